# Optimizing an MI355X kernel written in HIP

```python
import math
import jax, jax.numpy as jnp
from jax import lax
import numpy as np

D_MODEL = 2048
BATCH = 1
SEQ = 8192
DEPTH = 4
DEC_BATCH = 4
DEC_SEQ = 4096
PAST_LEN = 128

HEAD_DIM = 128
N_HEADS_A = 8
N_HEADS_B = 8
WIDTH_A = N_HEADS_A * HEAD_DIM
DQ_B = HEAD_DIM // 2
WIDTH_B = N_HEADS_B * HEAD_DIM
MIX_WIDTH = WIDTH_A + WIDTH_B
IN_WIDTH = 3 * WIDTH_A + 2 * (N_HEADS_B * 2 * DQ_B) + WIDTH_B
DILATED_CONFIGS = ((128, 1), (512, 4), (2048, 16))
D_FF = 5632
Q_BLOCK = 128
ALIBI_MAX_BIAS = 8.0
DEEPNORM_ALPHA = (2 * DEPTH) ** 0.25
DEEPNORM_BETA = (8 * DEPTH) ** -0.25
LN_EPS = 1e-5
RMS_EPS = 1e-6
NEG_INF = -1e30

kernel_name = "hymba_longnet_diffattn_macaron_deepnorm_encoder"


def layer_norm(x, g, b):
    xf = x.astype(jnp.float32)
    mu = xf.mean(-1, keepdims=True)
    var = jnp.square(xf - mu).mean(-1, keepdims=True)
    y = (xf - mu) * lax.rsqrt(var + LN_EPS)
    return (y * g.astype(jnp.float32) + b.astype(jnp.float32)).astype(x.dtype)


def rms_norm(x, g):
    xf = x.astype(jnp.float32)
    y = xf * lax.rsqrt(jnp.square(xf).mean(-1, keepdims=True) + RMS_EPS)
    return (y * g.astype(jnp.float32)).astype(x.dtype)


def swiglu(x, w_gate, w_up, w_down):
    return (jax.nn.silu(x @ w_gate) * (x @ w_up)) @ w_down


def alibi_slopes():
    n = N_HEADS_A + N_HEADS_B
    s = jnp.exp2(-ALIBI_MAX_BIAS * jnp.arange(1, n + 1, dtype=jnp.float32) / n)
    return s[0::2], s[1::2]


def dilated_branch(q, k, v, slopes, window, dil):
    B, S, H, D = q.shape
    R = (window // 2) // dil
    L = S // dil
    nb = -(-L // R)
    Lp = nb * R

    def to_sub(t):
        return t.reshape(B, L, dil, H, D).transpose(0, 2, 1, 3, 4)

    qb = jnp.pad(to_sub(q), ((0, 0), (0, 0), (0, Lp - L), (0, 0), (0, 0)))
    qb = qb.reshape(B, dil, nb, R, H, D)
    pad_kv = ((0, 0), (0, 0), (R, Lp - L + R), (0, 0), (0, 0))
    kp = jnp.pad(to_sub(k), pad_kv)
    vp = jnp.pad(to_sub(v), pad_kv)

    def band(t):
        return jnp.concatenate(
            [t[:, :, o * R:o * R + Lp].reshape(B, dil, nb, R, H, D) for o in range(3)], axis=3)

    kb, vb = band(kp), band(vp)
    s = jnp.einsum('bgnqhd,bgnkhd->bgnhqk', qb, kb,
                   preferred_element_type=jnp.float32) * (D ** -0.5)
    qi = jnp.arange(R)[:, None]
    kj = jnp.arange(3 * R)[None, :]
    delta = kj - R - qi
    key_idx = jnp.arange(nb)[:, None, None] * R - R + kj[None]
    valid = (jnp.abs(delta) <= R)[None] & (key_idx >= 0) & (key_idx < L)
    dist = (jnp.abs(delta) * dil).astype(jnp.float32)
    s = s - slopes[:, None, None] * dist
    s = jnp.where(valid[:, None], s, NEG_INF)
    m = s.max(-1, keepdims=True)
    e = jnp.exp(s - m)
    den = e.sum(-1, keepdims=True)
    o = jnp.einsum('bgnhqk,bgnkhd->bgnqhd', (e / den).astype(v.dtype), vb)
    lse = (m + jnp.log(den))[..., 0].transpose(0, 1, 2, 4, 3)
    o = o.reshape(B, dil, Lp, H, D)[:, :, :L].transpose(0, 2, 1, 3, 4).reshape(B, S, H, D)
    lse = lse.reshape(B, dil, Lp, H)[:, :, :L].transpose(0, 2, 1, 3).reshape(B, S, H)
    return o, lse


def dilated_attention(q, k, v, slopes):
    outs, lses = [], []
    for window, dil in DILATED_CONFIGS:
        o, l = dilated_branch(q, k, v, slopes, window, dil)
        outs.append(o)
        lses.append(l)
    w = jax.nn.softmax(jnp.stack(lses, 0), axis=0)
    out = jnp.sum(w[..., None] * jnp.stack(outs, 0).astype(jnp.float32), axis=0)
    return out.astype(q.dtype)


def diff_attention(q, k, v, slopes, lam):
    B, S, H, _, DQ = q.shape
    nq = S // Q_BLOCK
    qb = q.reshape(B, nq, Q_BLOCK, H, 2, DQ).transpose(1, 0, 2, 3, 4, 5)
    starts = jnp.arange(nq) * Q_BLOCK
    kpos = jnp.arange(S)

    def block(args):
        qblk, start = args
        s = jnp.einsum('bqhcd,bkhcd->bhcqk', qblk, k,
                       preferred_element_type=jnp.float32) * (DQ ** -0.5)
        dist = jnp.abs(start + jnp.arange(Q_BLOCK)[:, None] - kpos[None, :]).astype(jnp.float32)
        s = s - slopes[:, None, None, None] * dist
        p = jax.nn.softmax(s, axis=-1)
        a = p[:, :, 0] - lam * p[:, :, 1]
        return jnp.einsum('bhqk,bkhd->bqhd', a.astype(v.dtype), v)

    o = lax.map(block, (qb, starts))
    return o.transpose(1, 0, 2, 3, 4).reshape(B, S, H, 2 * DQ)


def setup_inputs(seed: int = 0) -> dict:
    key = jax.random.key(seed)
    ks = jax.random.split(key, 24)
    f32 = jnp.float32
    nrm = lambda k, shape, scale: jax.random.normal(k, shape, f32) * scale
    gain = lambda k, shape: 1.0 + 0.01 * jax.random.normal(k, shape, f32)
    return {
        "x_prompt": jax.random.normal(ks[0], (BATCH, SEQ, D_MODEL), f32),
        "x_sample": jax.random.normal(ks[1], (DEC_BATCH, DEC_SEQ, D_MODEL), f32),
        "ln1_g": gain(ks[2], (DEPTH, D_MODEL)),
        "ln1_b": nrm(ks[3], (DEPTH, D_MODEL), 0.01),
        "ffn1_gate": nrm(ks[4], (DEPTH, D_MODEL, D_FF), D_MODEL ** -0.5),
        "ffn1_up": nrm(ks[5], (DEPTH, D_MODEL, D_FF), D_MODEL ** -0.5),
        "ffn1_down": nrm(ks[6], (DEPTH, D_FF, D_MODEL), D_FF ** -0.5 * DEEPNORM_BETA),
        "w_in": nrm(ks[7], (DEPTH, D_MODEL, IN_WIDTH), D_MODEL ** -0.5),
        "norm_a_g": gain(ks[8], (DEPTH, HEAD_DIM)),
        "lam_q1": nrm(ks[9], (DEPTH, DQ_B), 0.1),
        "lam_k1": nrm(ks[10], (DEPTH, DQ_B), 0.1),
        "lam_q2": nrm(ks[11], (DEPTH, DQ_B), 0.1),
        "lam_k2": nrm(ks[12], (DEPTH, DQ_B), 0.1),
        "subln_g": gain(ks[13], (DEPTH, HEAD_DIM)),
        "w_out": nrm(ks[14], (DEPTH, MIX_WIDTH, D_MODEL), MIX_WIDTH ** -0.5 * DEEPNORM_BETA),
        "ln2_g": gain(ks[15], (DEPTH, D_MODEL)),
        "ln2_b": nrm(ks[16], (DEPTH, D_MODEL), 0.01),
        "ffn2_gate": nrm(ks[17], (DEPTH, D_MODEL, D_FF), D_MODEL ** -0.5),
        "ffn2_up": nrm(ks[18], (DEPTH, D_MODEL, D_FF), D_MODEL ** -0.5),
        "ffn2_down": nrm(ks[19], (DEPTH, D_FF, D_MODEL), D_FF ** -0.5 * DEEPNORM_BETA),
        "ln3_g": gain(ks[20], (DEPTH, D_MODEL)),
        "ln3_b": nrm(ks[21], (DEPTH, D_MODEL), 0.01),
    }


def reference(x_prompt, x_sample, ln1_g, ln1_b, ffn1_gate, ffn1_up, ffn1_down, w_in,
              norm_a_g, lam_q1, lam_k1, lam_q2, lam_k2, subln_g, w_out, ln2_g, ln2_b,
              ffn2_gate, ffn2_up, ffn2_down, ln3_g, ln3_b):
    slopes_a, slopes_b = alibi_slopes()

    def mixer(x, i):
        B, S, _ = x.shape
        h = x @ w_in[i]
        o0 = 3 * WIDTH_A
        qk_w = N_HEADS_B * 2 * DQ_B
        qa = h[..., 0:WIDTH_A].reshape(B, S, N_HEADS_A, HEAD_DIM)
        ka = h[..., WIDTH_A:2 * WIDTH_A].reshape(B, S, N_HEADS_A, HEAD_DIM)
        va = h[..., 2 * WIDTH_A:o0].reshape(B, S, N_HEADS_A, HEAD_DIM)
        qb = h[..., o0:o0 + qk_w].reshape(B, S, N_HEADS_B, 2, DQ_B)
        kb = h[..., o0 + qk_w:o0 + 2 * qk_w].reshape(B, S, N_HEADS_B, 2, DQ_B)
        vb = h[..., o0 + 2 * qk_w:].reshape(B, S, N_HEADS_B, 2 * DQ_B)
        ya = rms_norm(dilated_attention(qa, ka, va, slopes_a), norm_a_g[i])
        lam_init = 0.8 - 0.6 * math.exp(-0.3 * i)
        lam = (jnp.exp(jnp.sum(lam_q1[i].astype(jnp.float32) * lam_k1[i].astype(jnp.float32)))
               - jnp.exp(jnp.sum(lam_q2[i].astype(jnp.float32) * lam_k2[i].astype(jnp.float32)))
               + lam_init)
        yb = rms_norm(diff_attention(qb, kb, vb, slopes_b, lam), subln_g[i]) * (1.0 - lam_init)
        y = jnp.concatenate([ya.reshape(B, S, WIDTH_A), yb.reshape(B, S, WIDTH_B)], axis=-1)
        return y @ w_out[i]

    def trunk(x):
        for i in range(DEPTH):
            x = layer_norm(DEEPNORM_ALPHA * x + 0.5 * swiglu(x, ffn1_gate[i], ffn1_up[i], ffn1_down[i]),
                           ln1_g[i], ln1_b[i])
            x = layer_norm(DEEPNORM_ALPHA * x + mixer(x, i), ln2_g[i], ln2_b[i])
            x = layer_norm(DEEPNORM_ALPHA * x + 0.5 * swiglu(x, ffn2_gate[i], ffn2_up[i], ffn2_down[i]),
                           ln3_g[i], ln3_b[i])
        return x

    y_prompt = trunk(x_prompt)
    y_sample = trunk(x_sample)
    return (y_prompt, y_sample)
```

```cpp
#include <hip/hip_runtime.h>
#include <cstdio>
#include <cstdint>
#include <cmath>
#define MK_NAIVE_A 0
#define MK_NAIVE_B 0
#define MK_PER_PHASE 0
namespace pg8 {
#define PG8_LAS __attribute__((address_space(3)))
typedef unsigned short bf16_t;
typedef short bf16x8 __attribute__((ext_vector_type(8)));
typedef float f32x4 __attribute__((ext_vector_type(4)));
typedef unsigned u32x4 __attribute__((ext_vector_type(4)));
constexpr int BM = 256, BK = 64, HALF = 128, HTB = HALF * BK * 2  , STAGE_BYTES = 8 * HTB, NXCD = 8, WGM = 8;

__host__ __device__ __forceinline__ int lds_byte(int r, int c) { const int st = (r >> 4) * 2 + (c >> 5), rr = r & 15, cc = c & 31, ob = rr * 64 + cc * 2; return st * 1024 + (ob ^ (((ob >> 9) & 1) << 5)); }
__host__ __device__ __forceinline__ void stage_rc(int b, int& R, int& C) { const int st = b / 1024, sb = b % 1024, swz = sb ^ (((sb >> 9) & 1) << 5); R = (st >> 1) * 16 + swz / 64; C = (st & 1) * 32 + (swz % 64) / 2; }
__host__ __device__ __forceinline__ int perm32(int rho) { const int n = rho >> 4, i = rho & 15; return 8 * (i >> 2) + 4 * n + (i & 3); }

struct Unit { int pm, pn; };
struct Gemm { const bf16_t* A; const bf16_t* Bt; int M, N, K; };

struct StaticOrder {
    int nM, nN, nwg, G, c;
    __host__ __device__ void init(int M, int N, int G_, int c_) { nM = M / BM; nN = N / BM; nwg = nM * nN; G = G_; c = c_; }
    __host__ __device__ bool next(int i, Unit& u) const {
        const long L = (long)i * G + c; if (L >= nwg) return false;
        int wgid = (int)L; { const int q = nwg / NXCD, r = nwg % NXCD, xcd = wgid % NXCD, off = wgid / NXCD; wgid = (xcd < r ? xcd * (q + 1) : r * (q + 1) + (xcd - r) * q) + off; }
        const int nig = WGM * nN, gid = wgid / nig, fm = gid * WGM, gsz = (nM - fm) < WGM ? (nM - fm) : WGM;
        u.pm = fm + ((wgid % nig) % gsz); u.pn = (wgid % nig) / gsz; return true;
    }
    __device__ __forceinline__ void a_ready(const Unit&) const {}
    __device__ __forceinline__ void done(const Unit&) const {}
};

__device__ __forceinline__ unsigned cvt_pk_bf16(float lo, float hi) { unsigned r; asm volatile("v_cvt_pk_bf16_f32 %0, %1, %2" : "=v"(r) : "v"(lo), "v"(hi)); return r; }
__device__ __forceinline__ float silu_mul(float g, float u) {
    const float e = __builtin_amdgcn_exp2f(-1.4426950408889634f * g);
    return g * u * __builtin_amdgcn_rcpf(1.0f + e);
}
struct EpiSwiglu {
    static constexpr bool PERM = true, AFTER_DRAIN = false;
    bf16_t* H; int ldh;
    __device__ __forceinline__ void operator()(const f32x4 (&acc)[2][2][4][2], const Unit& u, int wr, int wc, int fr, int fq) const {
        const int row0 = u.pm * BM + wr * 64 + fr, col0 = u.pn * HALF + wc * 32 + 8 * fq;
#pragma unroll
        for (int ai = 0; ai < 2; ++ai)
#pragma unroll
            for (int m = 0; m < 4; ++m) {
                bf16_t* rowp = H + (size_t)(row0 + ai * HALF + m * 16) * ldh + col0;
                const f32x4 g0 = acc[ai][0][m][0], g1 = acc[ai][0][m][1], u0 = acc[ai][1][m][0], u1 = acc[ai][1][m][1];
                u32x4 w;
                w.x = cvt_pk_bf16(silu_mul(g0[0], u0[0]), silu_mul(g0[1], u0[1]));
                w.y = cvt_pk_bf16(silu_mul(g0[2], u0[2]), silu_mul(g0[3], u0[3]));
                w.z = cvt_pk_bf16(silu_mul(g1[0], u1[0]), silu_mul(g1[1], u1[1]));
                w.w = cvt_pk_bf16(silu_mul(g1[2], u1[2]), silu_mul(g1[3], u1[3]));
                *(u32x4*)rowp = w;
            }
    }
};
struct EpiBf16Plain {
    static constexpr bool PERM = true, AFTER_DRAIN = false;
    bf16_t* O; int ldc;
    __device__ __forceinline__ void operator()(const f32x4 (&acc)[2][2][4][2], const Unit& u, int wr, int wc, int fr, int fq) const {
        const int row0 = u.pm * BM + wr * 64 + fr, col0 = u.pn * BM + wc * 32 + 8 * fq;
#pragma unroll
        for (int ai = 0; ai < 2; ++ai)
#pragma unroll
            for (int m = 0; m < 4; ++m) {
                bf16_t* rowp = O + (size_t)(row0 + ai * HALF + m * 16) * ldc + col0;
#pragma unroll
                for (int bj = 0; bj < 2; ++bj) {
                    const f32x4 v0 = acc[ai][bj][m][0], v1 = acc[ai][bj][m][1];
                    u32x4 w; w.x = cvt_pk_bf16(v0[0], v0[1]); w.y = cvt_pk_bf16(v0[2], v0[3]); w.z = cvt_pk_bf16(v1[0], v1[1]); w.w = cvt_pk_bf16(v1[2], v1[3]);
                    *(u32x4*)(rowp + bj * HALF) = w;
                }
            }
    }
};
struct EpiResid {
    static constexpr bool PERM = false, AFTER_DRAIN = false;
    float* X; int ldc; float alpha, coef;
    __device__ __forceinline__ void operator()(const f32x4 (&acc)[2][2][4][2], const Unit& u, int wr, int wc, int fr, int fq) const {
        const int row0 = u.pm * BM + wr * 64 + fr, col0 = u.pn * BM + wc * 32 + 4 * fq;
#pragma unroll
        for (int ai = 0; ai < 2; ++ai)
#pragma unroll
            for (int m = 0; m < 4; ++m) {
                float* rowp = X + (size_t)(row0 + ai * HALF + m * 16) * ldc + col0;
#pragma unroll
                for (int bj = 0; bj < 2; ++bj)
#pragma unroll
                    for (int n = 0; n < 2; ++n) {
                        f32x4* p = (f32x4*)(rowp + bj * HALF + n * 16);
                        const f32x4 x = *p;
                        *p = x * alpha + acc[ai][bj][m][n] * coef;
                    }
                asm volatile("" ::: "memory");
            }
    }
};
template <class Epi, class Sched, bool ALIGN_EPI = false, bool SP2 = false>
__device__ __forceinline__ void gemm_phase(PG8_LAS unsigned char* lds, const Gemm g, const Sched& S, const Epi& E) {
    int tid_ = threadIdx.x; asm volatile("" : "+v"(tid_));
    const int tid = tid_, wid = __builtin_amdgcn_readfirstlane(tid >> 6), lane = tid & 63, wr = wid >> 2, wc = wid & 3, fr = lane & 15, fq = lane >> 4;
    const int K = g.K, nt = K / BK;
    unsigned voffA[2], voffB[2];
#pragma unroll
    for (int i = 0; i < 2; ++i) { int R, C; stage_rc(tid * 16 + i * 8192, R, C); const int Rb = Epi::PERM ? ((R & ~31) + perm32(R & 31)) : R;
        voffA[i] = (unsigned)(R * K + C) * 2u; voffB[i] = (unsigned)(Rb * K + C) * 2u; }
    const size_t kstep = (size_t)(BK * 2);
    const size_t hstep = (size_t)HALF * K * 2;
    const size_t tstep = 2 * hstep;
    const unsigned ldsw = (unsigned)wid * 1024u;
    const int aoff = lds_byte(wr * 64 + fr, fq * 8), boff = lds_byte(wc * 32 + fr, fq * 8);
#define PG8_SA(b, h) (((b) * 2 + (h)) * HTB)
#define PG8_SB(b, h) ((4 + (b) * 2 + (h)) * HTB)
#define PG8_STAGE(bufoff, gbase, voff) do { _Pragma("unroll") for (int _i = 0; _i < 2; ++_i) \
        __builtin_amdgcn_global_load_lds((const unsigned*)((const char*)(gbase) + (voff)[_i]), (PG8_LAS unsigned*)(lds + (bufoff) + ldsw + _i * 8192), 16, 0, 0); } while (0)
#define PG8_LDA(dst, b, h) do { _Pragma("unroll") for (int m = 0; m < 4; ++m) _Pragma("unroll") for (int k = 0; k < 2; ++k) dst[m][k] = *(const PG8_LAS bf16x8*)(lds + PG8_SA(b, h) + aoff + m * 2048 + k * 1024); } while (0)
#define PG8_LDB(dst, b, h) do { _Pragma("unroll") for (int n = 0; n < 2; ++n) _Pragma("unroll") for (int k = 0; k < 2; ++k) dst[n][k] = *(const PG8_LAS bf16x8*)(lds + PG8_SB(b, h) + boff + n * 2048 + k * 1024); } while (0)
#define PG8_MMA(ai, bj, At, Bt) do { __builtin_amdgcn_s_setprio(1); _Pragma("unroll") for (int m = 0; m < 4; ++m) _Pragma("unroll") for (int n = 0; n < 2; ++n) _Pragma("unroll") for (int k = 0; k < 2; ++k) \
        acc[ai][bj][m][n] = __builtin_amdgcn_mfma_f32_16x16x32_bf16(Bt[n][k], At[m][k], acc[ai][bj][m][n], 0, 0, 0); __builtin_amdgcn_s_setprio(0); } while (0)
#define PG8_WAIT_V(n) asm volatile("s_waitcnt vmcnt(" #n ")" ::: "memory")
#define PG8_WAIT_L(n) asm volatile("s_waitcnt lgkmcnt(" #n ")" ::: "memory")
#define PG8_BAR __builtin_amdgcn_s_barrier()
#define PG8_SCHED __builtin_amdgcn_sched_barrier(0)
    Unit cur, nxt; int ui = 0;
    if (!S.next(0, cur)) return;
    f32x4 acc[2][2][4][2];
#pragma unroll
    for (int a = 0; a < 2; ++a)
#pragma unroll
        for (int b = 0; b < 2; ++b)
#pragma unroll
            for (int m = 0; m < 4; ++m)
#pragma unroll
                for (int n = 0; n < 2; ++n) acc[a][b][m][n] = (f32x4){0.f, 0.f, 0.f, 0.f};
    bf16x8 At[4][2], B0[2][2], B1[2][2];
    const char* cA = (const char*)g.A + (size_t)cur.pm * tstep; const char* cB = (const char*)g.Bt + (size_t)cur.pn * tstep;
    S.a_ready(cur);
    if constexpr (SP2) {
        PG8_STAGE(PG8_SB(0, 0), cB, voffB); PG8_STAGE(PG8_SB(0, 1), cB + hstep, voffB); PG8_STAGE(PG8_SA(0, 0), cA, voffA); PG8_STAGE(PG8_SA(0, 1), cA + hstep, voffA);
        if (wr == 1) PG8_BAR;
        PG8_WAIT_V(2); PG8_BAR;
        PG8_STAGE(PG8_SB(1, 0), cB + kstep, voffB); PG8_STAGE(PG8_SA(1, 0), cA + kstep, voffA); PG8_STAGE(PG8_SB(1, 1), cB + hstep + kstep, voffB);
        PG8_WAIT_V(6); PG8_BAR;
    } else {
        PG8_STAGE(PG8_SB(0, 0), cB, voffB); PG8_STAGE(PG8_SA(0, 0), cA, voffA); PG8_STAGE(PG8_SB(0, 1), cB + hstep, voffB); PG8_STAGE(PG8_SA(0, 1), cA + hstep, voffA);
        if (wr == 1) PG8_BAR;
        PG8_WAIT_V(4); PG8_BAR;
        PG8_STAGE(PG8_SB(1, 0), cB + kstep, voffB); PG8_STAGE(PG8_SA(1, 0), cA + kstep, voffA); PG8_STAGE(PG8_SB(1, 1), cB + hstep + kstep, voffB);
        PG8_WAIT_V(6); PG8_BAR;
    }
    for (;;) {
        const bool has_next = S.next(ui + 1, nxt);
        const char* nA = has_next ? (const char*)g.A + (size_t)nxt.pm * tstep : cA; const char* nB = has_next ? (const char*)g.Bt + (size_t)nxt.pn * tstep : cB;
        for (int t = 0; t < nt; t += 2) {
            const bool last = (t == nt - 2);
            const char* a1 = cA + (size_t)(t + 1) * kstep;
            const char* a2 = last ? nA : cA + (size_t)(t + 2) * kstep; const char* b2 = last ? nB : cB + (size_t)(t + 2) * kstep;
            const char* a3 = a2 + kstep; const char* b3 = b2 + kstep;
            if (last && has_next) S.a_ready(nxt);
            if constexpr (SP2) {
            PG8_LDB(B0, 0, 0); PG8_LDB(B1, 0, 1); PG8_SCHED; PG8_LDA(At, 0, 0); PG8_STAGE(PG8_SA(1, 1), a1 + hstep, voffA);
            PG8_WAIT_V(8); PG8_WAIT_L(0); PG8_BAR; PG8_MMA(0, 0, At, B0); PG8_MMA(0, 1, At, B1); PG8_BAR; PG8_SCHED;
            PG8_LDA(At, 0, 1); PG8_STAGE(PG8_SB(0, 0), b2, voffB); PG8_STAGE(PG8_SB(0, 1), b2 + hstep, voffB); PG8_STAGE(PG8_SA(0, 0), a2, voffA);
            PG8_WAIT_V(8); PG8_WAIT_L(0); PG8_BAR; PG8_MMA(1, 0, At, B0); PG8_MMA(1, 1, At, B1); PG8_BAR; PG8_SCHED;
            PG8_LDB(B0, 1, 0); PG8_LDB(B1, 1, 1); PG8_SCHED; PG8_LDA(At, 1, 0); PG8_STAGE(PG8_SA(0, 1), a2 + hstep, voffA);
            PG8_WAIT_V(8); PG8_WAIT_L(0); PG8_BAR; PG8_MMA(0, 0, At, B0); PG8_MMA(0, 1, At, B1); PG8_BAR; PG8_SCHED;
            PG8_LDA(At, 1, 1); PG8_STAGE(PG8_SB(1, 0), b3, voffB); PG8_STAGE(PG8_SB(1, 1), b3 + hstep, voffB); PG8_STAGE(PG8_SA(1, 0), a3, voffA);
            PG8_WAIT_V(8); PG8_WAIT_L(0); PG8_BAR; PG8_MMA(1, 0, At, B0); PG8_MMA(1, 1, At, B1); PG8_BAR; PG8_SCHED;
            } else {
            PG8_LDB(B0, 0, 0); PG8_SCHED; PG8_LDA(At, 0, 0); PG8_STAGE(PG8_SA(1, 1), a1 + hstep, voffA);
            PG8_WAIT_L(8); PG8_BAR; PG8_WAIT_L(0); PG8_MMA(0, 0, At, B0); PG8_BAR; PG8_SCHED;
            PG8_LDB(B1, 0, 1); PG8_STAGE(PG8_SB(0, 0), b2, voffB);
            PG8_BAR; PG8_WAIT_L(0); PG8_MMA(0, 1, At, B1); PG8_BAR;
            PG8_LDA(At, 0, 1); PG8_STAGE(PG8_SA(0, 0), a2, voffA);
            PG8_BAR; PG8_WAIT_L(0); PG8_MMA(1, 0, At, B0); PG8_BAR; PG8_SCHED;
            PG8_STAGE(PG8_SB(0, 1), b2 + hstep, voffB);
            PG8_WAIT_V(6); PG8_BAR; PG8_MMA(1, 1, At, B1); PG8_BAR;
            PG8_LDB(B0, 1, 0); PG8_SCHED; PG8_LDA(At, 1, 0); PG8_STAGE(PG8_SA(0, 1), a2 + hstep, voffA);
            PG8_WAIT_L(8); PG8_BAR; PG8_WAIT_L(0); PG8_MMA(0, 0, At, B0); PG8_BAR; PG8_SCHED;
            PG8_LDB(B1, 1, 1); PG8_STAGE(PG8_SB(1, 0), b3, voffB);
            PG8_BAR; PG8_WAIT_L(0); PG8_MMA(0, 1, At, B1); PG8_BAR;
            PG8_LDA(At, 1, 1); PG8_STAGE(PG8_SA(1, 0), a3, voffA);
            PG8_BAR; PG8_WAIT_L(0); PG8_MMA(1, 0, At, B0); PG8_BAR; PG8_SCHED;
            PG8_STAGE(PG8_SB(1, 1), b3 + hstep, voffB);
            PG8_WAIT_V(6); PG8_BAR; PG8_MMA(1, 1, At, B1); PG8_BAR;
            }
        }
        if constexpr (ALIGN_EPI) { if (wr == 0) PG8_BAR; }
        if constexpr (!Epi::AFTER_DRAIN) { E(acc, cur, wr, wc, fr, fq); S.done(cur); }
        if (!has_next) break;
#pragma unroll
        for (int a = 0; a < 2; ++a)
#pragma unroll
            for (int b = 0; b < 2; ++b)
#pragma unroll
                for (int m = 0; m < 4; ++m)
#pragma unroll
                    for (int n = 0; n < 2; ++n) acc[a][b][m][n] = (f32x4){0.f, 0.f, 0.f, 0.f};
        cur = nxt; cA = nA; cB = nB; ++ui;
        if constexpr (ALIGN_EPI) { if (wr == 1) PG8_BAR; }
    }
    PG8_WAIT_V(0);
    if constexpr (!ALIGN_EPI) { if (wr == 0) PG8_BAR; }
    PG8_BAR;
    if constexpr (Epi::AFTER_DRAIN) { E.fused(acc, cur, wr, wc, fr, fq, lds, wid, lane); S.done(cur); }
#undef PG8_SA
#undef PG8_SB
#undef PG8_STAGE
#undef PG8_LDA
#undef PG8_LDB
#undef PG8_MMA
#undef PG8_WAIT_V
#undef PG8_WAIT_L
#undef PG8_BAR
#undef PG8_SCHED
}
}
#define GAS __attribute__((address_space(1)))
#define LAS __attribute__((address_space(3)))
typedef unsigned short bf16;
typedef unsigned v4u __attribute__((ext_vector_type(4)));
typedef float f32x4 __attribute__((ext_vector_type(4)));
typedef short bf16x8 __attribute__((ext_vector_type(8)));
typedef GAS unsigned gu32;
typedef GAS unsigned long long gu64;
#define RLX_AGENT __ATOMIC_RELAXED, __HIP_MEMORY_SCOPE_AGENT
#define LDS_WAIT() asm volatile("s_waitcnt lgkmcnt(0)" ::: "memory")
#define VM_WAIT() asm volatile("s_waitcnt vmcnt(0)" ::: "memory")
__device__ __forceinline__ unsigned long long rt() { return __builtin_amdgcn_s_memrealtime(); }
__device__ __forceinline__ unsigned f2bf(float f) { unsigned u = __builtin_bit_cast(unsigned, f); return (u + 0x7fffu + ((u >> 16) & 1u)) >> 16; }
__device__ __forceinline__ unsigned pk2(float lo, float hi) { return f2bf(lo) | (f2bf(hi) << 16); }

#define XB_TMO      128
#define XB_XCNT(j)  (256  + 64 * (j))
#define XB_XSUB(j)  (1280 + 64 * (j))
#define XB_XGEN(j)  (2304 + 64 * (j))
#define XB_TOP      3328
#define XB_TOPGEN   3392
#define XCD_BAR_WORDS 3456
#define XB_SPIN_CAP (1u << 18)

__device__ __forceinline__ unsigned xb_ld(unsigned* p)              { return __hip_atomic_load(p, __ATOMIC_RELAXED, __HIP_MEMORY_SCOPE_AGENT); }
__device__ __forceinline__ unsigned xb_add(unsigned* p, unsigned v) { return __hip_atomic_fetch_add(p, v, __ATOMIC_RELAXED, __HIP_MEMORY_SCOPE_AGENT); }
__device__ __forceinline__ unsigned xb_xcc_id() { return (unsigned)__builtin_amdgcn_s_getreg((3 << 11) | 20) & 0xFu; }
#define XB_SPIN(cond, bar) do { unsigned _sp = 0; while (cond) { __builtin_amdgcn_s_sleep(1); \
    if ((++_sp & 255u) == 0u) { if (xb_ld(&(bar)[XB_TMO])) break; if (_sp > XB_SPIN_CAP) { atomicAdd(&(bar)[XB_TMO], 1u); break; } } } } while (0)

struct XcdBarrier {
    unsigned* bar; unsigned x;
    volatile LAS unsigned* st;
};

__device__ __forceinline__ XcdBarrier xcd_barrier_post(unsigned* bar, volatile LAS unsigned* st) {
    XcdBarrier b; b.bar = bar; b.x = xb_xcc_id(); b.st = st;
    if (threadIdx.x == 0) (void)xb_add(&bar[XB_XCNT(b.x)], 1u);
    return b;
}
__device__ __forceinline__ void xcd_barrier_complete(unsigned* bar, unsigned x, unsigned& nloc, unsigned& nx) {
    const unsigned G = gridDim.x * gridDim.y * gridDim.z;
    unsigned sum, cnt, mine, sp = 0u;
    for (;;) {
        sum = 0u; cnt = 0u; mine = 0u;
#pragma unroll
        for (unsigned j = 0; j < 16; ++j) { const unsigned c = xb_ld(&bar[XB_XCNT(j)]); sum += c; cnt += (c > 0u) ? 1u : 0u; mine = (j == x) ? c : mine; }
        if (sum == G) break;
        __builtin_amdgcn_s_sleep(1);
        if ((++sp & 255u) == 0u) { if (xb_ld(&bar[XB_TMO])) break; if (sp > XB_SPIN_CAP) { atomicAdd(&bar[XB_TMO], 1u); break; } }
    }
    nloc = mine > 0u ? mine : 1u; nx = cnt > 0u ? cnt : 1u;
}

__device__ __forceinline__ void xcd_barrier(const XcdBarrier& b) {
    asm volatile("s_waitcnt vmcnt(0)" ::: "memory");
    __syncthreads();
    if (threadIdx.x == 0) {
        unsigned* bar = b.bar;
        __builtin_amdgcn_s_waitcnt(0);
        unsigned nloc = b.st[0], nx = b.st[1];
        if (nloc == 0u) { xcd_barrier_complete(bar, b.x, nloc, nx); b.st[0] = nloc; b.st[1] = nx; }
        const unsigned old = xb_add(&bar[XB_XSUB(b.x)], 1u);
        const unsigned gen = old / nloc;
        if (old + 1u == (gen + 1u) * nloc) {
            __builtin_amdgcn_fence(__ATOMIC_RELEASE, "agent");
            asm volatile("s_waitcnt vmcnt(0)" ::: "memory");
            const unsigned og = xb_add(&bar[XB_TOP], 1u);
            const unsigned tg = og / nx;
            if (og + 1u == (tg + 1u) * nx) xb_add(&bar[XB_TOPGEN], 1u);
            else XB_SPIN(xb_ld(&bar[XB_TOPGEN]) == tg, bar);
            __builtin_amdgcn_fence(__ATOMIC_ACQUIRE, "agent");
            xb_add(&bar[XB_XGEN(b.x)], 1u);
            asm volatile("s_waitcnt vmcnt(0)" ::: "memory");
        } else {
            XB_SPIN(xb_ld(&bar[XB_XGEN(b.x)]) == gen, bar);
            __builtin_amdgcn_fence(__ATOMIC_ACQUIRE, "agent");
            asm volatile("s_waitcnt vmcnt(0)" ::: "memory");
        }
    }
    __syncthreads();
}
constexpr int NWAVES = 8;
constexpr int DM = 2048, DFF = 5632, NFF2 = 2 * DFF, NTOK = 24576, INW = 6144, DEPTH = 4, NIN = 22;
constexpr int S_PROMPT = 8192, S_SAMPLE = 4096;
constexpr float ALPHA = 1.6817928305074290f;
constexpr float LN_EPS = 1e-5f, RMS_EPS = 1e-6f;
constexpr size_t MiB = 1u << 20;
constexpr size_t WS_CTL = 0, CTL_ZERO_BYTES = 1 * MiB;
constexpr size_t SZ_W1 = (size_t)NFF2 * DM * 2, SZ_WD = (size_t)DM * DFF * 2, SZ_WIN = (size_t)INW * DM * 2, SZ_WOUT = (size_t)DM * DM * 2;
constexpr size_t OFF_W1A = 0, OFF_WD1 = OFF_W1A + SZ_W1, OFF_WIN = OFF_WD1 + SZ_WD, OFF_WOUT = OFF_WIN + SZ_WIN, OFF_W2A = OFF_WOUT + SZ_WOUT, OFF_WD2 = OFF_W2A + SZ_W1;
constexpr size_t SZ_LAYER = OFF_WD2 + SZ_WD;
constexpr size_t WS_W = 2 * MiB;
constexpr size_t SZ_XN = (size_t)NTOK * DM * 2;
constexpr size_t WS_XN = WS_W + DEPTH * SZ_LAYER;
constexpr size_t WS_Y = WS_XN + SZ_XN;
constexpr size_t WS_QKV = WS_Y + SZ_XN;
constexpr size_t SZ_QKV = (size_t)NTOK * INW * 2;
constexpr size_t WS_OA = WS_QKV + SZ_QKV;
constexpr size_t SZ_OA1 = (size_t)NTOK * 1024 * 2;
constexpr size_t WS_LSE = WS_OA + 3 * SZ_OA1;
constexpr size_t SZ_LSE1 = (size_t)NTOK * 8 * 4;
constexpr size_t WS_END = WS_LSE + 3 * SZ_LSE1;
constexpr size_t WS_OT = WS_END;
constexpr size_t WS_END_NAIVE = WS_OT + (size_t)2 * NTOK * 1024 * 4;
constexpr int CW_TMO = 0, CW_CODE = 1, CW_BAR = 4096;
static_assert((CW_BAR + XCD_BAR_WORDS) * 4 <= (int)CTL_ZERO_BYTES, "ctl");
constexpr int RING_OFF = 0, RING_BYTES = 131072;
constexpr int LDSCTL_OFF = RING_BYTES, MISC_OFF = LDSCTL_OFF + 320;
constexpr int LDS_BYTES = 147456;
constexpr int PH_PER_LAYER = 11, N_PHASES = 1 + DEPTH * PH_PER_LAYER;

struct Frame {
    LAS unsigned char* lds;
    volatile LAS unsigned* MISC;
    gu32* ctl;
    int tid, lane, wave, vcu, G;
};
__device__ __forceinline__ float wave_sum(float v) {
#pragma unroll
    for (int o = 1; o < 64; o <<= 1) v += __shfl_xor(v, o);
    return v;
}
__device__ __forceinline__ float bf2f(bf16 v) { return __uint_as_float((unsigned)v << 16); }
__device__ __forceinline__ void seq_of(int tok, int& base, int& S) { if (tok < S_PROMPT) { base = 0; S = S_PROMPT; } else { base = S_PROMPT + (((tok - S_PROMPT) >> 12) << 12); S = S_SAMPLE; } }

namespace att {
using s16x4  = __attribute__((ext_vector_type(4))) short;
using f32x16 = __attribute__((ext_vector_type(16))) float;
using u32x4  = __attribute__((ext_vector_type(4))) unsigned;
constexpr int QKV_LD = 6144;
constexpr int SHM_V = 64 * 128 * 2, SHM_K = 64 * 128 * 2;
constexpr int LDS_WSF = 2 * SHM_V + 2 * SHM_K;
constexpr int ATT_LDS_BYTES = LDS_WSF + 8 * 64 * 4;
constexpr float LOG2E = 1.4426950408889634f;
#define KSWZ(row, colB) ((row) * 256 + ((colB) ^ (((row) & 7) << 4)))
#define SBAR() __builtin_amdgcn_sched_barrier(0)
__device__ __forceinline__ int crow(int r, int hi) { return (r & 3) + 8 * (r >> 2) + 4 * hi; }
__device__ __forceinline__ unsigned cvtpk(float lo, float hi) { unsigned r; asm volatile("v_cvt_pk_bf16_f32 %0, %1, %2" : "=v"(r) : "v"(lo), "v"(hi)); return r; }
__device__ __forceinline__ int v_st(int k, int c) { const int kk = (k & ~0xC) | ((k & 4) << 1) | ((k & 8) >> 1); return ((kk >> 3) * 4 + (c >> 5)) * 512 + ((kk & 7) * 32 + (c & 31)) * 2; }
__device__ __forceinline__ int v_rd_base(int lane) { return ((lane & 3) << 3) | (((lane >> 2) & 3) << 6) | (((lane >> 4) & 1) << 5) | (((lane >> 5) & 1) << 8); }
constexpr int v_rd_off(int d0, int ks, int half) { return d0 * 512 + ks * 4096 + half * 2048; }
template <int OFF> __device__ __forceinline__ s16x4 tr_read(int vb) { s16x4 r; asm volatile("ds_read_b64_tr_b16 %0, %1 offset:%2" : "=&v"(r) : "v"(vb), "i"(OFF) : "memory"); return r; }
template <int D0> __device__ __forceinline__ void pv_one(f32x16& od, int vb, bf16x8 pa0, bf16x8 pa1, bf16x8 pa2, bf16x8 pa3) {
  const s16x4 l0 = tr_read<v_rd_off(D0, 0, 0)>(vb), h0 = tr_read<v_rd_off(D0, 0, 1)>(vb), l1 = tr_read<v_rd_off(D0, 1, 0)>(vb), h1 = tr_read<v_rd_off(D0, 1, 1)>(vb);
  const s16x4 l2 = tr_read<v_rd_off(D0, 2, 0)>(vb), h2 = tr_read<v_rd_off(D0, 2, 1)>(vb), l3 = tr_read<v_rd_off(D0, 3, 0)>(vb), h3 = tr_read<v_rd_off(D0, 3, 1)>(vb);
  asm volatile("s_waitcnt lgkmcnt(0)" ::: "memory"); SBAR();
#define PK(L, H) (bf16x8){L[0], L[1], L[2], L[3], H[0], H[1], H[2], H[3]}
  od = __builtin_amdgcn_mfma_f32_32x32x16_bf16(pa0, PK(l0, h0), od, 0, 0, 0);
  od = __builtin_amdgcn_mfma_f32_32x32x16_bf16(pa1, PK(l1, h1), od, 0, 0, 0);
  od = __builtin_amdgcn_mfma_f32_32x32x16_bf16(pa2, PK(l2, h2), od, 0, 0, 0);
  od = __builtin_amdgcn_mfma_f32_32x32x16_bf16(pa3, PK(l3, h3), od, 0, 0, 0);
#undef PK
}
__device__ __forceinline__ void pv_d0(f32x16* o, int vb, bf16x8 pa0, bf16x8 pa1, bf16x8 pa2, bf16x8 pa3) {
  pv_one<0>(o[0], vb, pa0, pa1, pa2, pa3); pv_one<1>(o[1], vb, pa0, pa1, pa2, pa3); pv_one<2>(o[2], vb, pa0, pa1, pa2, pa3); pv_one<3>(o[3], vb, pa0, pa1, pa2, pa3);
}
__device__ __forceinline__ void finishSM(f32x16& p0, f32x16& p1, float alpha, float& l_reg, bf16x8& pa0, bf16x8& pa1, bf16x8& pa2, bf16x8& pa3) {
#pragma unroll
  for (int r = 0; r < 16; ++r) p1[r] = __builtin_amdgcn_exp2f(p1[r]);
  float ps = 0;
#pragma unroll
  for (int r = 0; r < 16; ++r) ps += p0[r];
#pragma unroll
  for (int r = 0; r < 16; ++r) ps += p1[r];
  { auto rr = __builtin_amdgcn_permlane32_swap(__float_as_uint(ps), __float_as_uint(ps), false, false); ps = __uint_as_float(rr[0]) + __uint_as_float(rr[1]); }
  l_reg = l_reg * alpha + ps;
#define PK4(P, BASE, OUT) do { unsigned a0 = cvtpk(P[BASE + 0], P[BASE + 1]), a1 = cvtpk(P[BASE + 2], P[BASE + 3]);   \
    unsigned b0 = cvtpk(P[BASE + 4], P[BASE + 5]), b1 = cvtpk(P[BASE + 6], P[BASE + 7]);                              \
    auto r0 = __builtin_amdgcn_permlane32_swap(a0, b0, false, false); auto r1 = __builtin_amdgcn_permlane32_swap(a1, b1, false, false); \
    u32x4 w = {r0[0], r1[0], r0[1], r1[1]}; OUT = *reinterpret_cast<bf16x8*>(&w); } while (0)
  PK4(p0, 0, pa0); PK4(p0, 8, pa1); PK4(p1, 0, pa2); PK4(p1, 8, pa3);
#undef PK4
}
template <int ND0> __device__ __forceinline__ void qkt(f32x16& p0, f32x16& p1, const char* Ks, const bf16x8* qr, int cb0, int r32, int hi) {
  p0 = f32x16{}; p1 = f32x16{};
#pragma unroll
  for (int d0 = 0; d0 < ND0; ++d0) { const int cb = cb0 + (d0 * 16 + hi * 8) * 2;
    const bf16x8 b0 = *reinterpret_cast<const bf16x8*>(Ks + KSWZ(r32, cb));
    const bf16x8 b1 = *reinterpret_cast<const bf16x8*>(Ks + KSWZ(32 + r32, cb));
    p0 = __builtin_amdgcn_mfma_f32_32x32x16_bf16(b0, qr[d0], p0, 0, 0, 0);
    p1 = __builtin_amdgcn_mfma_f32_32x32x16_bf16(b1, qr[d0], p1, 0, 0, 0); }
}
__device__ __forceinline__ float half_sum(float v) {
#pragma unroll
  for (int o = 1; o < 32; o <<= 1) v += __shfl_xor(v, o);
  return v;
}

constexpr float THR2 = 8.f * LOG2E;
__device__ __forceinline__ void partialSM_B(f32x16& p0, f32x16& p1, float& m_reg, float& mn, float& alpha, float dlt, float nslope) {
  constexpr float C = 0.125f * LOG2E;
#pragma unroll
  for (int r = 0; r < 16; ++r) { const float kc = (float)((r & 3) + 8 * (r >> 2));
    p0[r] = fmaf(p0[r], C, fabsf(dlt - kc) * nslope); p1[r] = fmaf(p1[r], C, fabsf(dlt - (kc + 32.f)) * nslope); }
  float pmax = p0[0];
#pragma unroll
  for (int r = 1; r < 16; ++r) pmax = fmaxf(pmax, p0[r]);
#pragma unroll
  for (int r = 0; r < 16; ++r) pmax = fmaxf(pmax, p1[r]);
  { auto rr = __builtin_amdgcn_permlane32_swap(__float_as_uint(pmax), __float_as_uint(pmax), false, false); pmax = fmaxf(__uint_as_float(rr[0]), __uint_as_float(rr[1])); }
  if (__builtin_expect(__all(pmax - m_reg <= THR2), 1)) { mn = m_reg; alpha = 1.f; }
  else { mn = fmaxf(m_reg, pmax); alpha = __builtin_amdgcn_exp2f(m_reg - mn); m_reg = mn; }
#pragma unroll
  for (int r = 0; r < 16; ++r) p0[r] = __builtin_amdgcn_exp2f(p0[r] - mn);
#pragma unroll
  for (int r = 0; r < 16; ++r) p1[r] -= mn;
}
__device__ __forceinline__ void attn_b_unit(const bf16* __restrict__ QKV, bf16* __restrict__ Y, int base, int S, int h, int q0, float lam, const float* __restrict__ subg, float outscale, char* lds) {
  int tid_ = threadIdx.x; asm volatile("" : "+v"(tid_));
  const int tid = tid_, wid = __builtin_amdgcn_readfirstlane(tid >> 6), lane = tid & 63, r32 = lane & 31, hi = lane >> 5, cmap = wid >> 2, wq = wid & 3;
  char* V_lds = lds; char* K_lds = lds + 2 * SHM_V;
  float* ws = (float*)(lds + LDS_WSF) + wid * 64; float* li_l = ws; float* al_l = ws + 32;
  float m_reg = -1e30f, l_reg = 0; f32x16 o[4] = {}; bf16x8 qr[4];
  const int qi = q0 + wq * 32 + r32;
  const bf16* Qw = QKV + (size_t)(base + qi) * QKV_LD + 3072 + h * 128 + cmap * 64 + hi * 8;
#pragma unroll
  for (int d0 = 0; d0 < 4; ++d0) qr[d0] = *reinterpret_cast<const bf16x8*>(Qw + d0 * 16);
  const bf16* Kh = QKV + (size_t)base * QKV_LD + 4096 + h * 128; const bf16* Vh = QKV + (size_t)base * QKV_LD + 5120 + h * 128;
  const int sr = tid >> 4, sc = (tid & 15) * 8, vst0 = v_st(sr, sc), vst1 = v_st(32 + sr, sc);
  const int vb0 = (int)(uintptr_t)V_lds + v_rd_base(lane);
  const int cb0 = cmap * 128;
  const float nslope = -LOG2E * __builtin_amdgcn_exp2f(-(float)(h + 1));
  const float dl0 = (float)(qi - 4 * hi);
  struct { bf16x8 vs0, vs1, ks0, ks1; } sr_[2];
#define SLOAD(i, k0) do { sr_[i].vs0 = *(const bf16x8*)(&Vh[(size_t)((k0) + sr) * QKV_LD + sc]); sr_[i].vs1 = *(const bf16x8*)(&Vh[(size_t)((k0) + 32 + sr) * QKV_LD + sc]); \
    sr_[i].ks0 = *(const bf16x8*)(&Kh[(size_t)((k0) + sr) * QKV_LD + sc]); sr_[i].ks1 = *(const bf16x8*)(&Kh[(size_t)((k0) + 32 + sr) * QKV_LD + sc]); } while (0)
#define SWRITE(b, i) do { *(bf16x8*)(V_lds + (b) * SHM_V + vst0) = sr_[i].vs0; *(bf16x8*)(V_lds + (b) * SHM_V + vst1) = sr_[i].vs1; const int kc_ = sc * 2; \
    *(bf16x8*)(K_lds + (b) * SHM_K + KSWZ(sr, kc_)) = sr_[i].ks0; *(bf16x8*)(K_lds + (b) * SHM_K + KSWZ(32 + sr, kc_)) = sr_[i].ks1; } while (0)
#define SWAIT() asm volatile("s_waitcnt vmcnt(4)" ::: "memory")
#define RESC(a) do { if (__any((a) < 1.f)) { if (hi == 0) al_l[r32] = (a); asm volatile("s_waitcnt lgkmcnt(0)" ::: "memory"); \
    _Pragma("unroll") for (int d = 0; d < 4; ++d) _Pragma("unroll") for (int r = 0; r < 16; ++r) o[d][r] *= al_l[crow(r, hi)]; } } while (0)
  f32x16 pA0, pA1, pB0, pB1; float mnA, mnB, alA, alB; bf16x8 pa0, pa1, pa2, pa3; const int NT = S / 64;
  constexpr int SE = 0, SO = 1;
  SLOAD(SE, 0); asm volatile("s_waitcnt vmcnt(0)" ::: "memory"); SWRITE(0, SE); __syncthreads();
  qkt<4>(pA0, pA1, K_lds, qr, cb0, r32, hi); partialSM_B(pA0, pA1, m_reg, mnA, alA, dl0, nslope);
  SLOAD(SO, 64); if (2 < NT) SLOAD(SE, 128);
  SWAIT(); SWRITE(1, SO); __syncthreads();
  for (int j = 1; j + 1 < NT; j += 2) {
    SBAR(); qkt<4>(pB0, pB1, K_lds + SHM_K, qr, cb0, r32, hi);
    finishSM(pA0, pA1, alA, l_reg, pa0, pa1, pa2, pa3); SBAR();
    SLOAD(SO, (j + 2) * 64); SBAR();
    pv_d0(o, vb0, pa0, pa1, pa2, pa3); partialSM_B(pB0, pB1, m_reg, mnB, alB, dl0 - (float)(j * 64), nslope);
    __syncthreads(); SWAIT(); SWRITE(0, SE);
    RESC(alB); __syncthreads();
    SBAR(); qkt<4>(pA0, pA1, K_lds, qr, cb0, r32, hi);
    finishSM(pB0, pB1, alB, l_reg, pa0, pa1, pa2, pa3); SBAR();
    if (j + 3 < NT) SLOAD(SE, (j + 3) * 64); SBAR();
    pv_d0(o, vb0 + SHM_V, pa0, pa1, pa2, pa3); partialSM_B(pA0, pA1, m_reg, mnA, alA, dl0 - (float)((j + 1) * 64), nslope);
    __syncthreads(); SWAIT(); SWRITE(1, SO);
    RESC(alA); __syncthreads();
  }
  SBAR(); qkt<4>(pB0, pB1, K_lds + SHM_K, qr, cb0, r32, hi);
  finishSM(pA0, pA1, alA, l_reg, pa0, pa1, pa2, pa3); SBAR();
  pv_d0(o, vb0, pa0, pa1, pa2, pa3); partialSM_B(pB0, pB1, m_reg, mnB, alB, dl0 - (float)((NT - 1) * 64), nslope);
  __syncthreads(); RESC(alB);
  finishSM(pB0, pB1, alB, l_reg, pa0, pa1, pa2, pa3); SBAR();
  pv_d0(o, vb0 + SHM_V, pa0, pa1, pa2, pa3);
  if (hi == 0) li_l[r32] = l_reg; asm volatile("s_waitcnt lgkmcnt(0)" ::: "memory");
  float rli[16];
#pragma unroll
  for (int r = 0; r < 16; ++r) rli[r] = __builtin_amdgcn_rcpf(li_l[crow(r, hi)]);
  __syncthreads();
  float* X = (float*)lds + wq * (32 * 128);
  if (cmap == 1) {
#pragma unroll
    for (int r = 0; r < 16; ++r)
#pragma unroll
      for (int d0 = 0; d0 < 4; ++d0) X[crow(r, hi) * 128 + d0 * 32 + r32] = o[d0][r] * (rli[r] * lam);
  }
  __syncthreads();
  if (cmap == 0) {
    float gv[4];
#pragma unroll
    for (int d0 = 0; d0 < 4; ++d0) gv[d0] = subg[d0 * 32 + r32] * outscale;
#pragma unroll
    for (int r = 0; r < 16; ++r) { float ss = 0.f;
#pragma unroll
      for (int d0 = 0; d0 < 4; ++d0) { const float v = o[d0][r] * rli[r] - X[crow(r, hi) * 128 + d0 * 32 + r32]; o[d0][r] = v; ss += v * v; }
      ss = half_sum(ss);
      const float rstd = 1.0f / sqrtf(ss * (1.f / 128.f) + 1e-6f);
#pragma unroll
      for (int d0 = 0; d0 < 4; ++d0) o[d0][r] *= rstd * gv[d0]; }
    asm volatile("s_waitcnt lgkmcnt(0)" ::: "memory");
    bf16* stg = (bf16*)X;
#pragma unroll
    for (int r = 0; r < 16; ++r)
#pragma unroll
      for (int d0 = 0; d0 < 4; ++d0) stg[crow(r, hi) * 128 + d0 * 32 + r32] = (bf16)(cvtpk(o[d0][r], 0.f) & 0xffffu);
    asm volatile("s_waitcnt lgkmcnt(0)" ::: "memory");
    bf16* Yw = Y + (size_t)(base + q0 + wq * 32) * 2048 + 1024 + h * 128;
#pragma unroll
    for (int i = 0; i < 8; ++i) { const int row = i * 4 + (lane >> 4), ch = lane & 15; const u32x4 v = *(const u32x4*)(stg + row * 128 + ch * 8); *(u32x4*)(Yw + (size_t)row * 2048 + ch * 8) = v; }
  }
  __syncthreads();
#undef SLOAD
#undef SWRITE
#undef SWAIT
#undef RESC
}

__device__ __forceinline__ void attn_a_unit(const bf16* __restrict__ QKV, bf16* __restrict__ OA, float* __restrict__ LSE, int base, int L, int dil, int rho, int a, int h, char* lds) {
  int tid_ = threadIdx.x; asm volatile("" : "+v"(tid_));
  const int tid = tid_, wid = __builtin_amdgcn_readfirstlane(tid >> 6), lane = tid & 63, r32 = lane & 31, hi = lane >> 5;
  char* V_lds = lds; char* K_lds = lds + 2 * SHM_V;
  float* ws = (float*)(lds + LDS_WSF) + wid * 64; float* li_l = ws; float* al_l = ws + 32;
  float m_reg = -1e30f, l_reg = 0; f32x16 o[4] = {}; bf16x8 qr[8];
  const int qs = a + wid * 32 + r32;
  const bf16* Qw = QKV + (size_t)(base + rho + dil * qs) * QKV_LD + h * 128 + hi * 8;
#pragma unroll
  for (int d0 = 0; d0 < 8; ++d0) qr[d0] = *reinterpret_cast<const bf16x8*>(Qw + d0 * 16);
  const bf16* Kh = QKV + (size_t)(base + rho) * QKV_LD + 1024 + h * 128; const bf16* Vh = Kh + 1024;
  const int sr = tid >> 4, sc = (tid & 15) * 8, vst0 = v_st(sr, sc), vst1 = v_st(32 + sr, sc);
  const int vb0 = (int)(uintptr_t)V_lds + v_rd_base(lane);
  constexpr float C = 0.08838834764831845f * LOG2E;
  const float nslope = -LOG2E * (float)dil * __builtin_amdgcn_exp2f(-0.5f * (float)(2 * h + 1));
  struct { bf16x8 vs0, vs1, ks0, ks1; } st;
  const size_t rstride = (size_t)dil * QKV_LD;
#define SLOADA(t) do { int k0_ = a - 64 + 64 * (t) + sr, k1_ = k0_ + 32; k0_ = k0_ < 0 ? 0 : (k0_ >= L ? L - 1 : k0_); k1_ = k1_ < 0 ? 0 : (k1_ >= L ? L - 1 : k1_); \
    st.vs0 = *(const bf16x8*)(&Vh[(size_t)k0_ * rstride + sc]); st.vs1 = *(const bf16x8*)(&Vh[(size_t)k1_ * rstride + sc]); \
    st.ks0 = *(const bf16x8*)(&Kh[(size_t)k0_ * rstride + sc]); st.ks1 = *(const bf16x8*)(&Kh[(size_t)k1_ * rstride + sc]); } while (0)
#define SWRITEA(b) do { *(bf16x8*)(V_lds + (b) * SHM_V + vst0) = st.vs0; *(bf16x8*)(V_lds + (b) * SHM_V + vst1) = st.vs1; const int kc_ = sc * 2; \
    *(bf16x8*)(K_lds + (b) * SHM_K + KSWZ(sr, kc_)) = st.ks0; *(bf16x8*)(K_lds + (b) * SHM_K + KSWZ(32 + sr, kc_)) = st.ks1; } while (0)
  SLOADA(0); asm volatile("s_waitcnt vmcnt(0)" ::: "memory"); SWRITEA(0); __syncthreads();
  const int t_lo = wid >> 1;
#pragma unroll 1
  for (int t = 0; t < 6; ++t) {
    const int b = t & 1;
    if (t + 1 < 6) SLOADA(t + 1);
    if (t >= t_lo && t <= t_lo + 2) {
      f32x16 p0, p1;
      qkt<8>(p0, p1, K_lds + b * SHM_K, qr, 0, r32, hi);
      const int kb = a - 64 + 64 * t + 4 * hi;
      const float dlt = (float)(qs - kb);
#pragma unroll
      for (int r = 0; r < 16; ++r) { const int kci = (r & 3) + 8 * (r >> 2); const float kc = (float)kci;
        const float u0 = fabsf(dlt - kc), u1 = fabsf(dlt - (kc + 32.f));
        const bool ok0 = (u0 <= 64.f) && ((unsigned)(kb + kci) < (unsigned)L), ok1 = (u1 <= 64.f) && ((unsigned)(kb + kci + 32) < (unsigned)L);
        p0[r] = ok0 ? fmaf(p0[r], C, u0 * nslope) : -INFINITY; p1[r] = ok1 ? fmaf(p1[r], C, u1 * nslope) : -INFINITY; }
      float pmax = p0[0];
#pragma unroll
      for (int r = 1; r < 16; ++r) pmax = fmaxf(pmax, p0[r]);
#pragma unroll
      for (int r = 0; r < 16; ++r) pmax = fmaxf(pmax, p1[r]);
      { auto rr = __builtin_amdgcn_permlane32_swap(__float_as_uint(pmax), __float_as_uint(pmax), false, false); pmax = fmaxf(__uint_as_float(rr[0]), __uint_as_float(rr[1])); }
      const float mn = fmaxf(m_reg, pmax), alpha = __builtin_amdgcn_exp2f(m_reg - mn); m_reg = mn;
#pragma unroll
      for (int r = 0; r < 16; ++r) { p0[r] = __builtin_amdgcn_exp2f(p0[r] - mn); p1[r] -= mn; }
      bf16x8 pa0, pa1, pa2, pa3;
      finishSM(p0, p1, alpha, l_reg, pa0, pa1, pa2, pa3);
      if (__any(alpha < 1.f)) { if (hi == 0) al_l[r32] = alpha; asm volatile("s_waitcnt lgkmcnt(0)" ::: "memory");
#pragma unroll
        for (int d = 0; d < 4; ++d)
#pragma unroll
          for (int r = 0; r < 16; ++r) o[d][r] *= al_l[crow(r, hi)]; }
      SBAR();
      pv_d0(o, vb0 + b * SHM_V, pa0, pa1, pa2, pa3);
    }
    if (t + 1 < 6) { asm volatile("s_waitcnt vmcnt(0)" ::: "memory"); SWRITEA(b ^ 1); }
    __syncthreads();
  }
  if (hi == 0) li_l[r32] = l_reg; asm volatile("s_waitcnt lgkmcnt(0)" ::: "memory");
  float rli[16];
#pragma unroll
  for (int r = 0; r < 16; ++r) rli[r] = __builtin_amdgcn_rcpf(li_l[crow(r, hi)]);
  bf16* stg = (bf16*)lds + wid * (32 * 128);
#pragma unroll
  for (int r = 0; r < 16; ++r)
#pragma unroll
    for (int d0 = 0; d0 < 4; ++d0) stg[crow(r, hi) * 128 + d0 * 32 + r32] = (bf16)(cvtpk(o[d0][r] * rli[r], 0.f) & 0xffffu);
  asm volatile("s_waitcnt lgkmcnt(0)" ::: "memory");
  const size_t tok0 = (size_t)base + rho + (size_t)dil * (a + wid * 32);
#pragma unroll
  for (int i = 0; i < 8; ++i) { const int row = i * 4 + (lane >> 4), ch = lane & 15; const u32x4 v = *(const u32x4*)(stg + row * 128 + ch * 8);
    *(u32x4*)(OA + (tok0 + (size_t)dil * row) * 1024 + h * 128 + ch * 8) = v; }
  if (hi == 0) LSE[(tok0 + (size_t)dil * r32) * 8 + h] = m_reg + __builtin_amdgcn_logf(l_reg);
  __syncthreads();
#undef SLOADA
#undef SWRITEA
}
__device__ __forceinline__ void attn_a_merge_row(const bf16* __restrict__ OA, const float* __restrict__ LSE, bf16* __restrict__ Y, const float* __restrict__ g, int tok, int lane) {
  const int h = lane >> 3, dseg = (lane & 7) * 16;
  float w[3]; { const float l0 = LSE[(size_t)tok * 8 + h], l1 = LSE[((size_t)NTOK + tok) * 8 + h], l2 = LSE[((size_t)2 * NTOK + tok) * 8 + h];
    const float mx = fmaxf(l0, fmaxf(l1, l2)); w[0] = __builtin_amdgcn_exp2f(l0 - mx); w[1] = __builtin_amdgcn_exp2f(l1 - mx); w[2] = __builtin_amdgcn_exp2f(l2 - mx);
    const float rs = 1.f / (w[0] + w[1] + w[2]); w[0] *= rs; w[1] *= rs; w[2] *= rs; }
  float acc[16];
#pragma unroll
  for (int e = 0; e < 16; ++e) acc[e] = 0.f;
#pragma unroll
  for (int b = 0; b < 3; ++b) { const u32x4* p = (const u32x4*)(OA + ((size_t)b * NTOK + tok) * 1024 + h * 128 + dseg); const u32x4 v0 = p[0], v1 = p[1];
#pragma unroll
    for (int e = 0; e < 4; ++e) { acc[2 * e] += w[b] * __uint_as_float(v0[e] << 16); acc[2 * e + 1] += w[b] * __uint_as_float(v0[e] & 0xffff0000u);
                                  acc[8 + 2 * e] += w[b] * __uint_as_float(v1[e] << 16); acc[8 + 2 * e + 1] += w[b] * __uint_as_float(v1[e] & 0xffff0000u); } }
  float ss = 0.f;
#pragma unroll
  for (int e = 0; e < 16; ++e) ss += acc[e] * acc[e];
  ss += __shfl_xor(ss, 1); ss += __shfl_xor(ss, 2); ss += __shfl_xor(ss, 4);
  const float rstd = 1.0f / sqrtf(ss * (1.f / 128.f) + 1e-6f);
  u32x4 o0, o1;
#pragma unroll
  for (int e = 0; e < 4; ++e) { o0[e] = cvtpk(acc[2 * e] * rstd * g[dseg + 2 * e], acc[2 * e + 1] * rstd * g[dseg + 2 * e + 1]);
                                o1[e] = cvtpk(acc[8 + 2 * e] * rstd * g[dseg + 8 + 2 * e], acc[8 + 2 * e + 1] * rstd * g[dseg + 8 + 2 * e + 1]); }
  u32x4* yo = (u32x4*)(Y + (size_t)tok * 2048 + h * 128 + dseg); yo[0] = o0; yo[1] = o1;
}
#undef KSWZ
#undef SBAR
}
__device__ __forceinline__ void p0_transpose_item(const float* W, int K, int N, bf16* WT, int mode, LAS float* scr, int item, int lane) {
    const int nblk = N / 32, kb = item / nblk, nb = item % nblk, k0 = 64 * kb, n0 = 32 * nb;
    const int r0 = mode == 0 ? n0 : ((n0 >> 7) * 256 + (n0 & 127) + (mode == 2 ? 128 : 0));
#pragma unroll 8
    for (int i = 0; i < 32; ++i) { const int kk = 2 * i + (lane >> 5); scr[kk * 33 + (lane & 31)] = W[(size_t)(k0 + kk) * N + n0 + (lane & 31)]; }
    LDS_WAIT(); asm volatile("" ::: "memory");
    const int c = lane & 7;
#pragma unroll
    for (int j = 0; j < 4; ++j) { const int n = (lane >> 3) + 8 * j; const LAS float* s = scr + (8 * c) * 33 + n;
        v4u o; o.x = pk2(s[0 * 33], s[1 * 33]); o.y = pk2(s[2 * 33], s[3 * 33]); o.z = pk2(s[4 * 33], s[5 * 33]); o.w = pk2(s[6 * 33], s[7 * 33]);
        *(GAS v4u*)(WT + (size_t)(r0 + n) * K + k0 + 8 * c) = o; }
    LDS_WAIT(); asm volatile("" ::: "memory");
}
struct Args { const float* in[NIN]; float* out; unsigned char* ws; int ph_lo, ph_hi; };

__device__ __forceinline__ void p0_prologue(Frame& F, const Args& a) {
    LAS float* scr = (LAS float*)(F.lds + RING_OFF + F.wave * 16384);
    const int gw = F.vcu * NWAVES + F.wave, NGW = F.G * NWAVES;
    constexpr int I_GU = (DM / 64) * (DFF / 32), I_D = (DFF / 64) * (DM / 32), I_IN = (DM / 64) * (INW / 32), I_OUT = (DM / 64) * (DM / 32);
    constexpr int I_LAYER = 4 * I_GU + 2 * I_D + I_IN + I_OUT, NITEMS = DEPTH * I_LAYER;
    for (int it = gw; it < NITEMS; it += NGW) {
        const int l = it / I_LAYER; int r = it % I_LAYER;
        unsigned char* wl = a.ws + WS_W + (size_t)l * SZ_LAYER;
        if (r < I_GU) { p0_transpose_item(a.in[4] + (size_t)l * DM * DFF, DM, DFF, (bf16*)(wl + OFF_W1A), 1, scr, r, F.lane); continue; } r -= I_GU;
        if (r < I_GU) { p0_transpose_item(a.in[5] + (size_t)l * DM * DFF, DM, DFF, (bf16*)(wl + OFF_W1A), 2, scr, r, F.lane); continue; } r -= I_GU;
        if (r < I_D)  { p0_transpose_item(a.in[6] + (size_t)l * DFF * DM, DFF, DM, (bf16*)(wl + OFF_WD1), 0, scr, r, F.lane); continue; } r -= I_D;
        if (r < I_IN) { p0_transpose_item(a.in[7] + (size_t)l * DM * INW, DM, INW, (bf16*)(wl + OFF_WIN), 0, scr, r, F.lane); continue; } r -= I_IN;
        if (r < I_OUT){ p0_transpose_item(a.in[14] + (size_t)l * DM * DM, DM, DM, (bf16*)(wl + OFF_WOUT), 0, scr, r, F.lane); continue; } r -= I_OUT;
        if (r < I_GU) { p0_transpose_item(a.in[17] + (size_t)l * DM * DFF, DM, DFF, (bf16*)(wl + OFF_W2A), 1, scr, r, F.lane); continue; } r -= I_GU;
        if (r < I_GU) { p0_transpose_item(a.in[18] + (size_t)l * DM * DFF, DM, DFF, (bf16*)(wl + OFF_W2A), 2, scr, r, F.lane); continue; } r -= I_GU;
        p0_transpose_item(a.in[19] + (size_t)l * DFF * DM, DFF, DM, (bf16*)(wl + OFF_WD2), 0, scr, r, F.lane);
    }
    bf16* XN = (bf16*)(a.ws + WS_XN);
    for (int m = gw; m < NTOK; m += NGW) {
        const float* src = m < S_PROMPT ? a.in[0] + (size_t)m * DM : a.in[1] + (size_t)(m - S_PROMPT) * DM;
        const GAS f32x4* xr = (const GAS f32x4*)src + F.lane;
        GAS f32x4* orow = (GAS f32x4*)(a.out + (size_t)m * DM) + F.lane;
        GAS unsigned long long* o8 = (GAS unsigned long long*)(XN + (size_t)m * DM) + F.lane;
#pragma unroll
        for (int j = 0; j < 8; ++j) { const f32x4 v = xr[64 * j]; orow[64 * j] = v; o8[64 * j] = (unsigned long long)pk2(v.x, v.y) | ((unsigned long long)pk2(v.z, v.w) << 32); }
    }
}
__device__ __forceinline__ void ln_phase(Frame& F, float* X, bf16* XN, const float* g, const float* b) {
    int lane_ = F.lane; asm volatile("" : "+v"(lane_));
    const int gw = F.vcu * NWAVES + F.wave, NGW = F.G * NWAVES;
    for (int m = gw; m < NTOK; m += NGW) {
        GAS f32x4* xr = (GAS f32x4*)(X + (size_t)m * DM) + lane_;
        f32x4 v[8]; float s = 0.f;
#pragma unroll
        for (int j = 0; j < 8; ++j) { v[j] = xr[64 * j]; s += (v[j].x + v[j].y) + (v[j].z + v[j].w); }
        const float mean = wave_sum(s) * (1.f / DM); float s2 = 0.f;
#pragma unroll
        for (int j = 0; j < 8; ++j) { v[j] = v[j] - mean; s2 += (v[j].x * v[j].x + v[j].y * v[j].y) + (v[j].z * v[j].z + v[j].w * v[j].w); }
        const float rstd = 1.f / sqrtf(wave_sum(s2) * (1.f / DM) + LN_EPS);
        GAS unsigned long long* o8 = (GAS unsigned long long*)(XN + (size_t)m * DM) + lane_;
        const GAS f32x4* gr = (const GAS f32x4*)g + lane_; const GAS f32x4* br = (const GAS f32x4*)b + lane_;
#pragma unroll
        for (int j = 0; j < 8; ++j) { const f32x4 y = v[j] * rstd * gr[64 * j] + br[64 * j]; xr[64 * j] = y; o8[64 * j] = (unsigned long long)pk2(y.x, y.y) | ((unsigned long long)pk2(y.z, y.w) << 32); }
    }
}

#if MK_NAIVE_A || MK_NAIVE_B
__global__ void __launch_bounds__(128) naive_attn_a(const bf16* QKV, bf16* Y, const float* g) {
    const int bid = blockIdx.x, tok = bid >> 3, h = bid & 7, d = threadIdx.x;
    int base, S; seq_of(tok, base, S); const int t = tok - base;
    __shared__ float q[128]; __shared__ float sc[387]; __shared__ float red[128];
    q[d] = bf2f(QKV[(size_t)tok * INW + h * 128 + d]);
    __syncthreads();
    const float slope = exp2f(-0.5f * (float)(2 * h + 1));
    for (int kk = d; kk < 387; kk += 128) {
        const int br = kk / 129, j = kk % 129 - 64, dil = 1 << (2 * br), kt = t + j * dil;
        float s = -INFINITY;
        if (kt >= 0 && kt < S) { const bf16* kr = QKV + (size_t)(base + kt) * INW + 1024 + h * 128; float dot = 0.f; for (int e = 0; e < 128; ++e) dot += q[e] * bf2f(kr[e]);
            s = dot * 0.08838834764831845f - slope * (float)(abs(j) * dil); }
        sc[kk] = s;
    }
    __syncthreads();
    float m = -INFINITY; for (int kk = 0; kk < 387; ++kk) m = fmaxf(m, sc[kk]);
    float den = 0.f; for (int kk = 0; kk < 387; ++kk) den += expf(sc[kk] - m);
    float o = 0.f;
    for (int kk = 0; kk < 387; ++kk) { const int br = kk / 129, j = kk % 129 - 64, dil = 1 << (2 * br), kt = t + j * dil;
        if (kt >= 0 && kt < S) o += expf(sc[kk] - m) * bf2f(QKV[(size_t)(base + kt) * INW + 2048 + h * 128 + d]); }
    o /= den;
    red[d] = o * o; __syncthreads();
    float ss = 0.f; for (int e = 0; e < 128; ++e) ss += red[e];
    const float y = o * (1.0f / sqrtf(ss * (1.f / 128.f) + RMS_EPS)) * g[d];
    Y[(size_t)tok * DM + h * 128 + d] = (bf16)f2bf(y);
}
__global__ void __launch_bounds__(256) naive_attn_b(const bf16* QKV, float* OT) {
    const int qb = blockIdx.x, h = blockIdx.y, c = blockIdx.z >> 1, dh = blockIdx.z & 1;
    int base, S; seq_of(qb * 256, base, S);
    const int tok = qb * 256 + threadIdx.x, i = tok - base;
    float q[64], o[64];
    { const bf16* qp = QKV + (size_t)tok * INW + 3072 + h * 128 + c * 64;
#pragma unroll
      for (int e = 0; e < 64; ++e) { q[e] = bf2f(qp[e]) * 0.125f; o[e] = 0.f; } }
    float m = -1e30f, l = 0.f; const float slope = exp2f(-(float)(h + 1));
    for (int k = 0; k < S; ++k) {
        const bf16* kr = QKV + (size_t)(base + k) * INW + 4096 + h * 128 + c * 64;
        const bf16* vr = QKV + (size_t)(base + k) * INW + 5120 + h * 128 + dh * 64;
        float s = 0.f;
#pragma unroll
        for (int e = 0; e < 64; ++e) s += q[e] * bf2f(kr[e]);
        s -= slope * fabsf((float)(i - k));
        const float mn = fmaxf(m, s), corr = expf(m - mn), p = expf(s - mn);
        l = l * corr + p; m = mn;
#pragma unroll
        for (int e = 0; e < 64; ++e) o[e] = o[e] * corr + p * bf2f(vr[e]);
    }
    float* op = OT + ((size_t)c * NTOK + tok) * 1024 + h * 128 + dh * 64; const float rl = 1.f / l;
#pragma unroll
    for (int e = 0; e < 64; ++e) op[e] = o[e] * rl;
}
__global__ void __launch_bounds__(128) naive_comb_b(const float* OT, bf16* Y, const float* q1, const float* k1, const float* q2, const float* k2, const float* g, int layer) {
    const int tok = blockIdx.x >> 3, h = blockIdx.x & 7, d = threadIdx.x;
    float s1 = 0.f, s2 = 0.f; for (int e = 0; e < 64; ++e) { s1 += q1[e] * k1[e]; s2 += q2[e] * k2[e]; }
    const float lam_init = 0.8f - 0.6f * expf(-0.3f * (float)layer), lam = expf(s1) - expf(s2) + lam_init;
    __shared__ float red[128];
    const float v = OT[(size_t)tok * 1024 + h * 128 + d] - lam * OT[((size_t)NTOK + tok) * 1024 + h * 128 + d];
    red[d] = v * v; __syncthreads();
    float ss = 0.f; for (int e = 0; e < 128; ++e) ss += red[e];
    const float y = v * (1.0f / sqrtf(ss * (1.f / 128.f) + RMS_EPS)) * g[d] * (1.0f - lam_init);
    Y[(size_t)tok * DM + 1024 + h * 128 + d] = (bf16)f2bf(y);
}
#endif


__device__ __forceinline__ void attn_a_phase(Frame& F, const bf16* QKV, bf16* OA, float* LSE, char* lds) {
    for (int it = 0;; ++it) {
        const int uid = it * F.G + F.vcu; if (uid >= 2304) break;
        const int h = (uid >> 5) & 7, rem = (uid >> 8) * 32 + (uid & 31), br = rem / 96, blk = rem % 96, dil = 1 << (2 * br);
        int base, S, j; if (blk < 32) { base = 0; S = S_PROMPT; j = blk; } else { base = S_PROMPT + S_SAMPLE * ((blk - 32) >> 4); S = S_SAMPLE; j = (blk - 32) & 15; }
        const int rho = j % dil, n = j / dil, L = S / dil;
        att::attn_a_unit(QKV, OA + (size_t)br * NTOK * 1024, LSE + (size_t)br * NTOK * 8, base, L, dil, rho, n * 256, h, lds);
    }
}
__device__ __forceinline__ void attn_a_merge_phase(Frame& F, const bf16* OA, const float* LSE, bf16* Y, const float* g) {
    const int gw = F.vcu * NWAVES + F.wave, NGW = F.G * NWAVES;
    int lane_ = F.lane; asm volatile("" : "+v"(lane_));
    for (int m = gw; m < NTOK; m += NGW) att::attn_a_merge_row(OA, LSE, Y, g, m, lane_);
}
__device__ __forceinline__ void attn_b_phase(Frame& F, const bf16* QKV, bf16* Y, const float* q1, const float* k1, const float* q2, const float* k2, const float* subg, int layer, char* lds) {
    int lane_ = F.lane; asm volatile("" : "+v"(lane_));
    const float s1 = wave_sum(q1[lane_] * k1[lane_]), s2 = wave_sum(q2[lane_] * k2[lane_]);
    const float lam_init = 0.8f - 0.6f * expf(-0.3f * (float)layer), lam = expf(s1) - expf(s2) + lam_init;
    const int xcd = F.vcu >> 5, u = F.vcu & 31;
    for (int it = 0;; ++it) {
        int idx;
        if (F.G == 256) { if (it >= 6) break; idx = it < 2 ? xcd * 64 + it * 32 + u : 512 + (xcd * 4 + it - 2) * 32 + u; }
        else { idx = it * F.G + F.vcu; if (idx >= 1536) break; }
        int base, S, h, q0;
        if (idx < 512) { base = 0; S = S_PROMPT; h = idx >> 6; q0 = (idx & 63) * 128; }
        else { const int r = idx - 512, pair = r >> 5; base = S_PROMPT + S_SAMPLE * (pair >> 3); S = S_SAMPLE; h = pair & 7; q0 = (r & 31) * 128; }
        att::attn_b_unit(QKV, Y, base, S, h, q0, lam, subg, 1.0f - lam_init, lds);
    }
}
__global__ void __launch_bounds__(NWAVES * 64, 2) mk_fwd(Args args) {
    extern __shared__ __attribute__((aligned(16))) unsigned char lds[];
    Frame F;
    F.lds = (LAS unsigned char*)lds;
    F.MISC = (volatile LAS unsigned*)(F.lds + MISC_OFF);
    F.tid = threadIdx.x; F.lane = F.tid & 63; F.wave = __builtin_amdgcn_readfirstlane(F.tid >> 6);
    F.G = gridDim.x; { const int bx = blockIdx.x; F.vcu = (F.G % 8 == 0) ? (bx % 8) * (F.G / 8) + bx / 8 : bx; }
    unsigned char* ws = args.ws;
    F.ctl = (gu32*)(ws + WS_CTL);
    for (int u = F.tid; u < (LDS_BYTES - LDSCTL_OFF) / 4; u += NWAVES * 64) ((LAS unsigned*)(F.lds + LDSCTL_OFF))[u] = 0u;
    __syncthreads();
    const int lo = args.ph_lo, hi = args.ph_hi;
    XcdBarrier bar; bar.bar = (unsigned*)(F.ctl + CW_BAR); bar.x = 0; bar.st = nullptr;
    if (hi - lo > 1) bar = xcd_barrier_post((unsigned*)(F.ctl + CW_BAR), F.MISC + 8);
#define IN(k) (lo <= (k) && (k) < hi)
#define SEAM(k) do { if (IN(k) && IN((k) + 1)) xcd_barrier(bar); } while (0)
    bf16* XN = (bf16*)(ws + WS_XN); bf16* YB = (bf16*)(ws + WS_Y); bf16* QKV = (bf16*)(ws + WS_QKV); bf16* HB = (bf16*)(ws + WS_QKV);
    float* X = args.out;

    if (IN(0)) { p0_prologue(F, args); SEAM(0); }
    for (int l = 0; l < DEPTH; ++l) {
        const int pb = 1 + PH_PER_LAYER * l;
        unsigned char* wl = ws + WS_W + (size_t)l * SZ_LAYER;
        if (IN(pb + 0)) {
            pg8::Gemm g{XN, (const bf16*)(wl + OFF_W1A), NTOK, NFF2, DM}; pg8::StaticOrder S; S.init(NTOK, NFF2, F.G, (int)blockIdx.x);
            pg8::EpiSwiglu E{HB, DFF};
            pg8::gemm_phase<pg8::EpiSwiglu, pg8::StaticOrder, true, true>(F.lds + RING_OFF, g, S, E);
            SEAM(pb + 0);
        }
        if (IN(pb + 1)) {
            pg8::Gemm g{HB, (const bf16*)(wl + OFF_WD1), NTOK, DM, DFF}; pg8::StaticOrder S; S.init(NTOK, DM, F.G, (int)blockIdx.x);
            pg8::EpiResid E{X, DM, ALPHA, 0.5f};
            pg8::gemm_phase<pg8::EpiResid, pg8::StaticOrder, true, true>(F.lds + RING_OFF, g, S, E);
            SEAM(pb + 1);
        }
        if (IN(pb + 2)) { ln_phase(F, X, XN, args.in[2] + l * DM, args.in[3] + l * DM); SEAM(pb + 2); }
        if (IN(pb + 3)) {
            pg8::Gemm g{XN, (const bf16*)(wl + OFF_WIN), NTOK, INW, DM}; pg8::StaticOrder S; S.init(NTOK, INW, F.G, (int)blockIdx.x);
            pg8::EpiBf16Plain E{QKV, INW};
            pg8::gemm_phase<pg8::EpiBf16Plain, pg8::StaticOrder, true, true>(F.lds + RING_OFF, g, S, E);
            SEAM(pb + 3);
        }
        if (IN(pb + 4)) {
#if !MK_NAIVE_A
            attn_a_phase(F, QKV, (bf16*)(ws + WS_OA), (float*)(ws + WS_LSE), (char*)lds + RING_OFF);
#endif
            SEAM(pb + 4);
        }
        if (IN(pb + 5)) {
#if !MK_NAIVE_A
            attn_a_merge_phase(F, (const bf16*)(ws + WS_OA), (const float*)(ws + WS_LSE), YB, args.in[8] + l * 128);
#endif
#if !MK_NAIVE_B
            attn_b_phase(F, QKV, YB, args.in[9] + l * 64, args.in[10] + l * 64, args.in[11] + l * 64, args.in[12] + l * 64, args.in[13] + l * 128, l, (char*)lds + RING_OFF);
#endif
            SEAM(pb + 5);
        }
        if (IN(pb + 6)) {
            pg8::Gemm g{YB, (const bf16*)(wl + OFF_WOUT), NTOK, DM, DM}; pg8::StaticOrder S; S.init(NTOK, DM, F.G, (int)blockIdx.x);
            pg8::EpiResid E{X, DM, ALPHA, 1.0f};
            pg8::gemm_phase<pg8::EpiResid, pg8::StaticOrder, true, true>(F.lds + RING_OFF, g, S, E);
            SEAM(pb + 6);
        }
        if (IN(pb + 7)) { ln_phase(F, X, XN, args.in[15] + l * DM, args.in[16] + l * DM); SEAM(pb + 7); }
        if (IN(pb + 8)) {
            pg8::Gemm g{XN, (const bf16*)(wl + OFF_W2A), NTOK, NFF2, DM}; pg8::StaticOrder S; S.init(NTOK, NFF2, F.G, (int)blockIdx.x);
            pg8::EpiSwiglu E{HB, DFF};
            pg8::gemm_phase<pg8::EpiSwiglu, pg8::StaticOrder, true, true>(F.lds + RING_OFF, g, S, E);
            SEAM(pb + 8);
        }
        if (IN(pb + 9)) {
            pg8::Gemm g{HB, (const bf16*)(wl + OFF_WD2), NTOK, DM, DFF}; pg8::StaticOrder S; S.init(NTOK, DM, F.G, (int)blockIdx.x);
            pg8::EpiResid E{X, DM, ALPHA, 0.5f};
            pg8::gemm_phase<pg8::EpiResid, pg8::StaticOrder, true, true>(F.lds + RING_OFF, g, S, E);
            SEAM(pb + 9);
        }
        if (IN(pb + 10)) { ln_phase(F, X, XN, args.in[20] + l * DM, args.in[21] + l * DM); SEAM(pb + 10); }
    }
#undef IN
#undef SEAM
}

extern "C" void kernel_launch(void* const* d_in, const int* in_sizes, int n_in, void* d_out, int out_size, void* d_ws, size_t ws_size, hipStream_t stream) {
    static int grid = 0;
    if (grid == 0) {
        const size_t need = MK_NAIVE_B ? WS_END_NAIVE : WS_END;
        if (n_in != NIN || out_size != NTOK * DM || ws_size < need) { fprintf(stderr, "kernel_launch: shape mismatch n_in %d out %d ws %zu (need %zu)\n", n_in, out_size, ws_size, need); grid = -1; return; }
        int dev = 0, cus = 0;
        if (hipGetDevice(&dev) != hipSuccess || hipDeviceGetAttribute(&cus, hipDeviceAttributeMultiprocessorCount, dev) != hipSuccess) { grid = -1; return; }
        if (hipFuncSetAttribute((const void*)mk_fwd, hipFuncAttributeMaxDynamicSharedMemorySize, LDS_BYTES) != hipSuccess) { fprintf(stderr, "kernel_launch: hipFuncSetAttribute failed\n"); grid = -1; return; }
        int per_cu = 0;
        if (hipOccupancyMaxActiveBlocksPerMultiprocessor(&per_cu, (const void*)mk_fwd, NWAVES * 64, LDS_BYTES) != hipSuccess || per_cu < 1) fprintf(stderr, "kernel_launch: occupancy query says %d\n", per_cu);
        (void)hipGetLastError();
        grid = cus;
    }
    if (grid < 0) return;
    if (hipMemsetAsync((char*)d_ws + WS_CTL, 0, CTL_ZERO_BYTES, stream) != hipSuccess) return;
    Args a{};
    for (int i = 0; i < NIN; ++i) a.in[i] = (const float*)d_in[i];
    a.out = (float*)d_out; a.ws = (unsigned char*)d_ws;
#if MK_PER_PHASE
    unsigned char* ws = (unsigned char*)d_ws; (void)ws;
    for (int p = 0; p < N_PHASES; ++p) {
        const int k = p == 0 ? -1 : (p - 1) % PH_PER_LAYER, l = p == 0 ? 0 : (p - 1) / PH_PER_LAYER; (void)l;
#if MK_NAIVE_A
        if (k == 4) hipLaunchKernelGGL(naive_attn_a, dim3(NTOK * 8), dim3(128), 0, stream, (const bf16*)(ws + WS_QKV), (bf16*)(ws + WS_Y), (const float*)d_in[8] + l * 128);
#endif
#if MK_NAIVE_B
        if (k == 5) {
            hipLaunchKernelGGL(naive_attn_b, dim3(NTOK / 256, 8, 4), dim3(256), 0, stream, (const bf16*)(ws + WS_QKV), (float*)(ws + WS_OT));
            hipLaunchKernelGGL(naive_comb_b, dim3(NTOK * 8), dim3(128), 0, stream, (const float*)(ws + WS_OT), (bf16*)(ws + WS_Y),
                               (const float*)d_in[9] + l * 64, (const float*)d_in[10] + l * 64, (const float*)d_in[11] + l * 64, (const float*)d_in[12] + l * 64, (const float*)d_in[13] + l * 128, l);
        }
#endif
        if ((k == 4 && MK_NAIVE_A) || (k == 5 && MK_NAIVE_A && MK_NAIVE_B)) continue;
        a.ph_lo = p; a.ph_hi = p + 1;
        hipLaunchKernelGGL(mk_fwd, dim3(grid), dim3(NWAVES * 64), LDS_BYTES, stream, a);
    }
#else
    a.ph_lo = 0; a.ph_hi = N_PHASES;
    hipLaunchKernelGGL(mk_fwd, dim3(grid), dim3(NWAVES * 64), LDS_BYTES, stream, a);
#endif
    const hipError_t le = hipPeekAtLastError();
    if (le != hipSuccess) fprintf(stderr, "kernel_launch: launch failed: %s\n", hipGetErrorName(le));
}
```

```cpp
#include <hip/hip_runtime.h>
#include <cstdio>
#include <cstdint>
#include <cmath>
#define MK_NAIVE_A 0
#define MK_NAIVE_B 0
#define MK_PER_PHASE 0
#define MK_DUP_B 0
#define MK_DUP_UP 0
#define MK_DUP_A 0
#define MK_CV_TAIL_LO 2624
#define MK_AUX_RESID 0
#define MK_CIDX ((int)blockIdx.x)
#define MK_ALIGN_UP true
#define MK_B_STAGGER 1
#define MK_PAD_M 0
#define MK_PRIO_L 0
#define MK_PAD_L 0
#define MK_SP2 true
#define MK_ALIGN_RESID true
#define MK_G4TEST 0
#define MK_WT_STORES 0
#define MK_STAG50 0
#define MK_WGM_UP 8
#define MK_DUP_WIN 0
#define MK_DUP_DOWN 0
#define MK_DUP_WOUT 0
#define MK_NT_H 0
#define MK_BH32 1
#define MK_F16 0
#define MK_HI_ONLY 1
#define MK_ATOM2 0
#define MK_RESID_DEPTH 3
namespace pg8 {
#define PG8_LAS __attribute__((address_space(3)))
typedef unsigned short bf16_t;
typedef short bf16x8 __attribute__((ext_vector_type(8)));
typedef float f32x4 __attribute__((ext_vector_type(4)));
typedef unsigned u32x4 __attribute__((ext_vector_type(4)));
constexpr int BM = 256, BK = 64, HALF = 128, HTB = HALF * BK * 2  , STAGE_BYTES = 8 * HTB, NXCD = 8, WGM = 8;

__host__ __device__ __forceinline__ int lds_byte(int r, int c) { const int st = (r >> 4) * 2 + (c >> 5), rr = r & 15, cc = c & 31, ob = rr * 64 + cc * 2; return st * 1024 + (ob ^ (((ob >> 9) & 1) << 5)); }
__host__ __device__ __forceinline__ void stage_rc(int b, int& R, int& C) { const int st = b / 1024, sb = b % 1024, swz = sb ^ (((sb >> 9) & 1) << 5); R = (st >> 1) * 16 + swz / 64; C = (st & 1) * 32 + (swz % 64) / 2; }
__host__ __device__ __forceinline__ int perm32(int rho) { const int n = rho >> 4, i = rho & 15; return 8 * (i >> 2) + 4 * n + (i & 3); }

struct Unit { int pm, pn; };
struct Gemm { const bf16_t* A; const bf16_t* Bt; int M, N, K; };

struct StaticOrder {
    int nM, nN, nwg, G, c, wgm;
    __host__ __device__ void init(int M, int N, int G_, int c_, int wgm_ = WGM) { nM = M / BM; nN = N / BM; nwg = nM * nN; G = G_; c = c_; wgm = wgm_; }
    __host__ __device__ bool next(int i, Unit& u) const {
        const long L = (long)i * G + c; if (L >= nwg) return false;
        int wgid = (int)L; { const int q = nwg / NXCD, r = nwg % NXCD, xcd = wgid % NXCD, off = wgid / NXCD; wgid = (xcd < r ? xcd * (q + 1) : r * (q + 1) + (xcd - r) * q) + off; }
        const int nig = wgm * nN, gid = wgid / nig, fm = gid * wgm, gsz = (nM - fm) < wgm ? (nM - fm) : wgm;
        u.pm = fm + ((wgid % nig) % gsz); u.pn = (wgid % nig) / gsz; return true;
    }
    __device__ __forceinline__ void a_ready(const Unit&) const {}
    __device__ __forceinline__ void done(const Unit&) const {}
};

__device__ __forceinline__ unsigned cvt_pk_bf16(float lo, float hi) { unsigned r; asm volatile("v_cvt_pk_bf16_f32 %0, %1, %2" : "=v"(r) : "v"(lo), "v"(hi)); return r; }
#if MK_F16
typedef _Float16 op16x2 __attribute__((ext_vector_type(2)));
typedef _Float16 op16x8 __attribute__((ext_vector_type(8)));
__device__ __forceinline__ unsigned cvt_pk_op(float lo, float hi) { const op16x2 v = {(_Float16)lo, (_Float16)hi}; return __builtin_bit_cast(unsigned, v); }
__device__ __forceinline__ float op_lo(unsigned u) { return (float)__builtin_bit_cast(op16x2, u)[0]; }
__device__ __forceinline__ float op_hi(unsigned u) { return (float)__builtin_bit_cast(op16x2, u)[1]; }
#define PG8_MFMA_OP(b, a, c) __builtin_amdgcn_mfma_f32_16x16x32_f16(__builtin_bit_cast(pg8::op16x8, b), __builtin_bit_cast(pg8::op16x8, a), c, 0, 0, 0)
#else
__device__ __forceinline__ unsigned cvt_pk_op(float lo, float hi) { return cvt_pk_bf16(lo, hi); }
__device__ __forceinline__ float op_lo(unsigned u) { return __uint_as_float(u << 16); }
__device__ __forceinline__ float op_hi(unsigned u) { return __uint_as_float(u & 0xffff0000u); }
#define PG8_MFMA_OP(b, a, c) __builtin_amdgcn_mfma_f32_16x16x32_bf16(b, a, c, 0, 0, 0)
#endif
__device__ __forceinline__ float silu_mul2(float gp, float up) { return gp * up * __builtin_amdgcn_rcpf(1.0f + __builtin_amdgcn_exp2f(gp)); }
__device__ __forceinline__ float silu_mul(float g, float u) {
    const float e = __builtin_amdgcn_exp2f(-1.4426950408889634f * g);
    return g * u * __builtin_amdgcn_rcpf(1.0f + e);
}
constexpr float EPI_INV_D = 1.0f / 2048.0f, EPI_LN_EPS = 1e-5f;
#ifndef MK_WT_STORES
#define MK_WT_STORES 0
#endif
__device__ __forceinline__ void st16_wt(void* p, const u32x4& v) {
#if MK_WT_STORES
    asm volatile("global_store_dwordx4 %0, %1, off sc1" :: "v"(p), "v"(v) : "memory");
#else
    *(u32x4*)p = v;
#endif
}
typedef long long st_t; typedef int vec_t;
typedef long long i64x2 __attribute__((ext_vector_type(2)));
typedef int i32x4 __attribute__((ext_vector_type(4)));
constexpr float ST_SCALE = 16777216.0f, ST_INV = 1.0f / 16777216.0f, VEC_SCALE = 8388608.0f, VEC_INV = 1.0f / 8388608.0f;
__device__ __forceinline__ st_t st_fix(float v) { return (st_t)__builtin_rintf(v * ST_SCALE); }
__device__ __forceinline__ float st_val(st_t v) { return fmaf((float)(int)(v >> 32), 4294967296.0f, (float)(unsigned)v) * ST_INV; }
__device__ __forceinline__ f32x4 vec4(const vec_t* p) { const i32x4 v = *(const i32x4*)p; return (f32x4){(float)v[0] * VEC_INV, (float)v[1] * VEC_INV, (float)v[2] * VEC_INV, (float)v[3] * VEC_INV}; }
__device__ __forceinline__ void stats_of(const i64x2& s, float& mu, float& rstd) {
    mu = st_val(s[0]) * EPI_INV_D; rstd = __builtin_amdgcn_rsqf(fmaxf(st_val(s[1]) * EPI_INV_D - mu * mu, 0.f) + EPI_LN_EPS);
}
__device__ __forceinline__ void row_stats(const st_t* ST, int row, float& mu, float& rstd) { const i64x2 s = *(const i64x2*)(ST + 2 * (size_t)row); stats_of(s, mu, rstd); }
struct EpiSwigluLN {
    static constexpr bool PERM = true, AFTER_DRAIN = false, BH32 = false;
    bf16_t* H; int ldh; const st_t* ST; const vec_t* cs; const vec_t* bw;
    __device__ __forceinline__ void operator()(const f32x4 (&acc)[2][2][4][2], const Unit& u, int wr, int wc, int fr, int fq) const {
        const int row0 = u.pm * BM + wr * 64 + fr, col0 = u.pn * HALF + wc * 32 + 8 * fq, n0 = u.pn * BM + wc * 32 + 8 * fq;
        f32x4 csv[2][2], bwv[2][2];
#pragma unroll
        for (int bj = 0; bj < 2; ++bj)
#pragma unroll
            for (int n = 0; n < 2; ++n) { csv[bj][n] = vec4(cs + n0 + bj * HALF + 4 * n); bwv[bj][n] = vec4(bw + n0 + bj * HALF + 4 * n) * (bj == 0 ? -1.4426950408889634f : -0.6931471805599453f); }
        i64x2 stv[8];
#pragma unroll
        for (int i = 0; i < 8; ++i) stv[i] = *(const i64x2*)(ST + 2 * (size_t)(row0 + (i >> 2) * HALF + (i & 3) * 16));
#pragma unroll
        for (int ai = 0; ai < 2; ++ai)
#pragma unroll
            for (int m = 0; m < 4; ++m) {
                const int row = row0 + ai * HALF + m * 16;
                float mu, rstd; stats_of(stv[ai * 4 + m], mu, rstd);
                bf16_t* rowp = H + (size_t)row * ldh + col0;
                const float rg = rstd * -1.4426950408889634f, ru = rstd * -0.6931471805599453f;
                const f32x4 g0 = (acc[ai][0][m][0] - csv[0][0] * mu) * rg + bwv[0][0], g1 = (acc[ai][0][m][1] - csv[0][1] * mu) * rg + bwv[0][1];
                const f32x4 u0 = (acc[ai][1][m][0] - csv[1][0] * mu) * ru + bwv[1][0], u1 = (acc[ai][1][m][1] - csv[1][1] * mu) * ru + bwv[1][1];
                u32x4 w;
                w.x = cvt_pk_op(silu_mul2(g0[0], u0[0]), silu_mul2(g0[1], u0[1]));
                w.y = cvt_pk_op(silu_mul2(g0[2], u0[2]), silu_mul2(g0[3], u0[3]));
                w.z = cvt_pk_op(silu_mul2(g1[0], u1[0]), silu_mul2(g1[1], u1[1]));
                w.w = cvt_pk_op(silu_mul2(g1[2], u1[2]), silu_mul2(g1[3], u1[3]));
#if MK_NT_H
                __builtin_nontemporal_store(w, (u32x4*)rowp);
#else
                *(u32x4*)rowp = w;
#endif
            }
    }
};
struct EpiBf16LN {
    static constexpr bool PERM = true, AFTER_DRAIN = false, BH32 = false;
    bf16_t* O; int M; const st_t* ST; const vec_t* cs; const vec_t* bw;
    __device__ __forceinline__ void operator()(const f32x4 (&acc)[2][2][4][2], const Unit& u, int wr, int wc, int fr, int fq) const {
        const int row0 = u.pm * BM + wr * 64 + fr, col0 = u.pn * BM + wc * 32 + 8 * fq;
        f32x4 csv[2][2], bwv[2][2];
#pragma unroll
        for (int bj = 0; bj < 2; ++bj)
#pragma unroll
            for (int n = 0; n < 2; ++n) { csv[bj][n] = vec4(cs + col0 + bj * HALF + 4 * n); bwv[bj][n] = vec4(bw + col0 + bj * HALF + 4 * n); }
        i64x2 stv[8];
#pragma unroll
        for (int i = 0; i < 8; ++i) stv[i] = *(const i64x2*)(ST + 2 * (size_t)(row0 + (i >> 2) * HALF + (i & 3) * 16));
#pragma unroll
        for (int ai = 0; ai < 2; ++ai)
#pragma unroll
            for (int m = 0; m < 4; ++m) {
                const int row = row0 + ai * HALF + m * 16;
                float mu, rstd; stats_of(stv[ai * 4 + m], mu, rstd);
                bf16_t* rowp = O + ((size_t)(u.pn * 2) * M + row) * 128 + wc * 32 + 8 * fq;
#pragma unroll
                for (int bj = 0; bj < 2; ++bj) {
                    const f32x4 v0 = (acc[ai][bj][m][0] - csv[bj][0] * mu) * rstd + bwv[bj][0], v1 = (acc[ai][bj][m][1] - csv[bj][1] * mu) * rstd + bwv[bj][1];
                    u32x4 w; w.x = cvt_pk_bf16(v0[0], v0[1]); w.y = cvt_pk_bf16(v0[2], v0[3]); w.z = cvt_pk_bf16(v1[0], v1[1]); w.w = cvt_pk_bf16(v1[2], v1[3]);
                    *(u32x4*)(rowp + (size_t)bj * M * 128) = w;
                }
            }
    }
};
typedef unsigned u32x2 __attribute__((ext_vector_type(2)));
constexpr float LO_SCALE = 2048.0f, LO_INV = 1.0f / 2048.0f;
struct ResidLoads { u32x4 h0, h1; u32x2 l0, l1; i64x2 st; };
__device__ __forceinline__ f32x4 bf_lo4(const u32x4& h, const u32x2& l, int half) {
    const unsigned ha = h[2 * half], hb = h[2 * half + 1];
#if MK_HI_ONLY
    return (f32x4){op_lo(ha), op_hi(ha), op_lo(hb), op_hi(hb)};
#else
    const auto la = __builtin_amdgcn_cvt_pk_f32_fp8((int)l[half], false), lb = __builtin_amdgcn_cvt_pk_f32_fp8((int)l[half], true);
    return (f32x4){fmaf(la[0], LO_INV, op_lo(ha)), fmaf(la[1], LO_INV, op_hi(ha)),
                   fmaf(lb[0], LO_INV, op_lo(hb)), fmaf(lb[1], LO_INV, op_hi(hb))};
#endif
}
struct EpiResidLN {
    static constexpr bool PERM = true, AFTER_DRAIN = false, BH32 = (MK_BH32 != 0);
    static constexpr int CH = BH32 ? 32 : HALF, WCS = BH32 ? 64 : 32;
    bf16_t* YH; unsigned char* YL; bf16_t* YHo; unsigned char* YLo; int ldc; const st_t* STp; st_t* STn; const float* gp; const float* bp; float alpha, coef;
    __device__ __forceinline__ void issue(ResidLoads& L, int row, int col0) const {
        const size_t o = (size_t)row * ldc + col0;
        L.st = *(const i64x2*)(STp + 2 * (size_t)row);
        L.h0 = *(const u32x4*)(YH + o); L.h1 = *(const u32x4*)(YH + o + CH);
#if !MK_HI_ONLY
        L.l0 = *(const u32x2*)(YL + o); L.l1 = *(const u32x2*)(YL + o + CH);
#endif
    }
    __device__ __forceinline__ void split_store(bf16_t* ph, unsigned char* pl, const f32x4& a, const f32x4& b) const {
        u32x4 h; u32x2 l;
        h.x = cvt_pk_op(a[0], a[1]); h.y = cvt_pk_op(a[2], a[3]); h.z = cvt_pk_op(b[0], b[1]); h.w = cvt_pk_op(b[2], b[3]);
#if !MK_HI_ONLY
        int w0 = __builtin_amdgcn_cvt_pk_fp8_f32((a[0] - op_lo(h.x)) * LO_SCALE, (a[1] - op_hi(h.x)) * LO_SCALE, 0, false);
        w0 = __builtin_amdgcn_cvt_pk_fp8_f32((a[2] - op_lo(h.y)) * LO_SCALE, (a[3] - op_hi(h.y)) * LO_SCALE, w0, true);
        int w1 = __builtin_amdgcn_cvt_pk_fp8_f32((b[0] - op_lo(h.z)) * LO_SCALE, (b[1] - op_hi(h.z)) * LO_SCALE, 0, false);
        w1 = __builtin_amdgcn_cvt_pk_fp8_f32((b[2] - op_lo(h.w)) * LO_SCALE, (b[3] - op_hi(h.w)) * LO_SCALE, w1, true);
        l.x = (unsigned)w0; l.y = (unsigned)w1;
#endif
        *(u32x4*)ph = h;
#if !MK_HI_ONLY
        *(u32x2*)pl = l;
#endif
    }
    __device__ __forceinline__ void finish(const ResidLoads& L, int row, int col0, const f32x4& a00, const f32x4& a01, const f32x4& a10, const f32x4& a11,
                                           const f32x4 (&gv)[2][2], const f32x4 (&bv)[2][2], float& s, float& q) const {
        float mu, rstd; stats_of(L.st, mu, rstd);
        const size_t o = (size_t)row * ldc + col0;
        const f32x4 v00 = (bf_lo4(L.h0, L.l0, 0) - mu) * rstd * gv[0][0] + bv[0][0] + a00 * coef, v01 = (bf_lo4(L.h0, L.l0, 1) - mu) * rstd * gv[0][1] + bv[0][1] + a01 * coef;
        const f32x4 v10 = (bf_lo4(L.h1, L.l1, 0) - mu) * rstd * gv[1][0] + bv[1][0] + a10 * coef, v11 = (bf_lo4(L.h1, L.l1, 1) - mu) * rstd * gv[1][1] + bv[1][1] + a11 * coef;
        split_store(YHo + o, YLo + o, v00, v01); split_store(YHo + o + CH, YLo + o + CH, v10, v11);
        const f32x4 t = (v00 + v01) + (v10 + v11), t2 = (v00 * v00 + v01 * v01) + (v10 * v10 + v11 * v11);
        s = (t[0] + t[1]) + (t[2] + t[3]); q = (t2[0] + t2[1]) + (t2[2] + t2[3]);
        s += __shfl_xor(s, 16); s += __shfl_xor(s, 32); q += __shfl_xor(q, 16); q += __shfl_xor(q, 32);
    }
    __device__ __forceinline__ void operator()(const f32x4 (&acc)[2][2][4][2], const Unit& u, int wr, int wc, int fr, int fq) const {
        const int row0 = u.pm * BM + wr * 64 + fr, col0 = u.pn * BM + wc * WCS + 8 * fq;
#if MK_RESID_DEPTH == 3
        ResidLoads LQ[3];
#define RESID_ROW(i) (row0 + ((i) >> 2) * HALF + ((i) & 3) * 16)
        issue(LQ[0], row0, col0); issue(LQ[1], RESID_ROW(1), col0);
        f32x4 gv[2][2], bv[2][2];
#pragma unroll
        for (int bj = 0; bj < 2; ++bj)
#pragma unroll
            for (int n = 0; n < 2; ++n) { gv[bj][n] = *(const f32x4*)(gp + col0 + bj * CH + 4 * n) * alpha; bv[bj][n] = *(const f32x4*)(bp + col0 + bj * CH + 4 * n) * alpha; }
        float s_lo = 0.f, q_lo = 0.f, s_hi = 0.f, q_hi = 0.f;
#pragma unroll
        for (int i = 0; i < 8; ++i) {
            if (i + 2 < 8) issue(LQ[(i + 2) % 3], RESID_ROW(i + 2), col0);
            asm volatile("" ::: "memory");
            float s_, q_;
            finish(LQ[i % 3], RESID_ROW(i), col0, acc[i >> 2][0][i & 3][0], acc[i >> 2][0][i & 3][1], acc[i >> 2][1][i & 3][0], acc[i >> 2][1][i & 3][1], gv, bv, s_, q_);
            if (i < 4) { s_lo = fq == (i & 3) ? s_ : s_lo; q_lo = fq == (i & 3) ? q_ : q_lo; } else { s_hi = fq == (i & 3) ? s_ : s_hi; q_hi = fq == (i & 3) ? q_ : q_hi; }
            asm volatile("" ::: "memory");
        }
#undef RESID_ROW
#else
        ResidLoads LA, LB;
        issue(LA, row0, col0);
        f32x4 gv[2][2], bv[2][2];
#pragma unroll
        for (int bj = 0; bj < 2; ++bj)
#pragma unroll
            for (int n = 0; n < 2; ++n) { gv[bj][n] = *(const f32x4*)(gp + col0 + bj * CH + 4 * n) * alpha; bv[bj][n] = *(const f32x4*)(bp + col0 + bj * CH + 4 * n) * alpha; }
        float rs[8], rq[8];
#define RESID_ROW(i) (row0 + ((i) >> 2) * HALF + ((i) & 3) * 16)
#pragma unroll
        for (int i = 0; i < 8; i += 2) {
            issue(LB, RESID_ROW(i + 1), col0);
            asm volatile("" ::: "memory");
            finish(LA, RESID_ROW(i), col0, acc[i >> 2][0][i & 3][0], acc[i >> 2][0][i & 3][1], acc[i >> 2][1][i & 3][0], acc[i >> 2][1][i & 3][1], gv, bv, rs[i], rq[i]);
            asm volatile("" ::: "memory");
            if (i + 2 < 8) issue(LA, RESID_ROW(i + 2), col0);
            asm volatile("" ::: "memory");
            finish(LB, RESID_ROW(i + 1), col0, acc[(i + 1) >> 2][0][(i + 1) & 3][0], acc[(i + 1) >> 2][0][(i + 1) & 3][1], acc[(i + 1) >> 2][1][(i + 1) & 3][0], acc[(i + 1) >> 2][1][(i + 1) & 3][1], gv, bv, rs[i + 1], rq[i + 1]);
            asm volatile("" ::: "memory");
        }
#undef RESID_ROW
        const float s_lo = fq == 0 ? rs[0] : fq == 1 ? rs[1] : fq == 2 ? rs[2] : rs[3], q_lo = fq == 0 ? rq[0] : fq == 1 ? rq[1] : fq == 2 ? rq[2] : rq[3];
        const float s_hi = fq == 0 ? rs[4] : fq == 1 ? rs[5] : fq == 2 ? rs[6] : rs[7], q_hi = fq == 0 ? rq[4] : fq == 1 ? rq[5] : fq == 2 ? rq[6] : rq[7];
#endif
        st_t* p_lo = STn + 2 * (size_t)(row0 + fq * 16), * p_hi = STn + 2 * (size_t)(row0 + HALF + fq * 16);
        __hip_atomic_fetch_add(p_lo, st_fix(s_lo), __ATOMIC_RELAXED, __HIP_MEMORY_SCOPE_AGENT); __hip_atomic_fetch_add(p_lo + 1, st_fix(q_lo), __ATOMIC_RELAXED, __HIP_MEMORY_SCOPE_AGENT);
        __hip_atomic_fetch_add(p_hi, st_fix(s_hi), __ATOMIC_RELAXED, __HIP_MEMORY_SCOPE_AGENT); __hip_atomic_fetch_add(p_hi + 1, st_fix(q_hi), __ATOMIC_RELAXED, __HIP_MEMORY_SCOPE_AGENT);
    }
};
struct EpiNull {
    static constexpr bool PERM = true, AFTER_DRAIN = false, BH32 = false;
    __device__ __forceinline__ void operator()(const f32x4 (&acc)[2][2][4][2], const Unit&, int, int, int, int) const {
#pragma unroll
        for (int ai = 0; ai < 2; ++ai)
#pragma unroll
            for (int bj = 0; bj < 2; ++bj)
#pragma unroll
                for (int m = 0; m < 4; ++m)
#pragma unroll
                    for (int n = 0; n < 2; ++n) asm volatile("" :: "v"(acc[ai][bj][m][n]));
    }
};
template <class Epi, class Sched, bool ALIGN_EPI = false, bool SP2 = false, int AUX_A = 0  >
__device__ __forceinline__ void gemm_phase(PG8_LAS unsigned char* lds, const Gemm g, const Sched& S, const Epi& E) {
    int tid_ = threadIdx.x; asm volatile("" : "+v"(tid_));
    const int tid = tid_, wid = __builtin_amdgcn_readfirstlane(tid >> 6), lane = tid & 63, wr = wid >> 2, wc = wid & 3, fr = lane & 15, fq = lane >> 4;
    const int K = g.K, nt = K / BK;
    unsigned voffA[2], voffB[2];
#pragma unroll
    for (int i = 0; i < 2; ++i) { int R, C; stage_rc(tid * 16 + i * 8192, R, C); const int Rb = Epi::BH32 ? ((R >> 5) * 64 + perm32(R & 31)) : Epi::PERM ? ((R & ~31) + perm32(R & 31)) : R;
        voffA[i] = (unsigned)(R * K + C) * 2u; voffB[i] = (unsigned)(Rb * K + C) * 2u; }
    const size_t kstep = (size_t)(BK * 2);
    const size_t hstep = (size_t)HALF * K * 2;
    const size_t tstep = 2 * hstep;
    const size_t bhs = Epi::BH32 ? (size_t)32 * K * 2 : hstep;
    const unsigned ldsw = (unsigned)wid * 1024u;
    const int aoff = lds_byte(wr * 64 + fr, fq * 8), boff = lds_byte(wc * 32 + fr, fq * 8);
#define PG8_SA(b, h) (((b) * 2 + (h)) * HTB)
#define PG8_SB(b, h) ((4 + (b) * 2 + (h)) * HTB)
#define PG8_STAGE_X(bufoff, gbase, voff, aux) do { _Pragma("unroll") for (int _i = 0; _i < 2; ++_i) \
        __builtin_amdgcn_global_load_lds((const unsigned*)((const char*)(gbase) + (voff)[_i]), (PG8_LAS unsigned*)(lds + (bufoff) + ldsw + _i * 8192), 16, 0, (aux)); } while (0)
#define PG8_LDA(dst, b, h) do { _Pragma("unroll") for (int m = 0; m < 4; ++m) _Pragma("unroll") for (int k = 0; k < 2; ++k) dst[m][k] = *(const PG8_LAS bf16x8*)(lds + PG8_SA(b, h) + aoff + m * 2048 + k * 1024); } while (0)
#define PG8_LDB(dst, b, h) do { _Pragma("unroll") for (int n = 0; n < 2; ++n) _Pragma("unroll") for (int k = 0; k < 2; ++k) dst[n][k] = *(const PG8_LAS bf16x8*)(lds + PG8_SB(b, h) + boff + n * 2048 + k * 1024); } while (0)
#define PG8_MMA(ai, bj, At, Bt) do { __builtin_amdgcn_s_setprio(1); _Pragma("unroll") for (int m = 0; m < 4; ++m) _Pragma("unroll") for (int n = 0; n < 2; ++n) _Pragma("unroll") for (int k = 0; k < 2; ++k) \
        acc[ai][bj][m][n] = PG8_MFMA_OP(Bt[n][k], At[m][k], acc[ai][bj][m][n]); __builtin_amdgcn_s_setprio(0); } while (0)
#define PG8_WAIT_V(n) asm volatile("s_waitcnt vmcnt(" #n ")" ::: "memory")
#define PG8_WAIT_L(n) asm volatile("s_waitcnt lgkmcnt(" #n ")" ::: "memory")
#define PG8_BAR __builtin_amdgcn_s_barrier()
#define PG8_SCHED __builtin_amdgcn_sched_barrier(0)
    Unit cur, nxt; int ui = 0;
    if (!S.next(0, cur)) return;
    f32x4 acc[2][2][4][2];
#pragma unroll
    for (int a = 0; a < 2; ++a)
#pragma unroll
        for (int b = 0; b < 2; ++b)
#pragma unroll
            for (int m = 0; m < 4; ++m)
#pragma unroll
                for (int n = 0; n < 2; ++n) acc[a][b][m][n] = (f32x4){0.f, 0.f, 0.f, 0.f};
    bf16x8 At[4][2], B0[2][2], B1[2][2];
    const char* cA = (const char*)g.A + (size_t)cur.pm * tstep; const char* cB = (const char*)g.Bt + (size_t)cur.pn * tstep;
    S.a_ready(cur);
    if constexpr (SP2) {
        PG8_STAGE_X(PG8_SB(0, 0), cB, voffB, 0); PG8_STAGE_X(PG8_SB(0, 1), cB + bhs, voffB, 0); PG8_STAGE_X(PG8_SA(0, 0), cA, voffA, AUX_A); PG8_STAGE_X(PG8_SA(0, 1), cA + hstep, voffA, AUX_A);
        if (wr == 1) PG8_BAR;
        PG8_WAIT_V(2); PG8_BAR;
        PG8_STAGE_X(PG8_SB(1, 0), cB + kstep, voffB, 0); PG8_STAGE_X(PG8_SA(1, 0), cA + kstep, voffA, AUX_A); PG8_STAGE_X(PG8_SB(1, 1), cB + bhs + kstep, voffB, 0);
        PG8_WAIT_V(6); PG8_BAR;
    } else {
        PG8_STAGE_X(PG8_SB(0, 0), cB, voffB, 0); PG8_STAGE_X(PG8_SA(0, 0), cA, voffA, AUX_A); PG8_STAGE_X(PG8_SB(0, 1), cB + bhs, voffB, 0); PG8_STAGE_X(PG8_SA(0, 1), cA + hstep, voffA, AUX_A);
        if (wr == 1) PG8_BAR;
        PG8_WAIT_V(4); PG8_BAR;
        PG8_STAGE_X(PG8_SB(1, 0), cB + kstep, voffB, 0); PG8_STAGE_X(PG8_SA(1, 0), cA + kstep, voffA, AUX_A); PG8_STAGE_X(PG8_SB(1, 1), cB + bhs + kstep, voffB, 0);
        PG8_WAIT_V(6); PG8_BAR;
    }
    for (;;) {
        const bool has_next = S.next(ui + 1, nxt);
        const char* nA = has_next ? (const char*)g.A + (size_t)nxt.pm * tstep : cA; const char* nB = has_next ? (const char*)g.Bt + (size_t)nxt.pn * tstep : cB;
        for (int t = 0; t < nt; t += 2) {
            const bool last = (t == nt - 2);
            const char* a1 = cA + (size_t)(t + 1) * kstep;
            const char* a2 = last ? nA : cA + (size_t)(t + 2) * kstep; const char* b2 = last ? nB : cB + (size_t)(t + 2) * kstep;
            const char* a3 = a2 + kstep; const char* b3 = b2 + kstep;
            if (last && has_next) S.a_ready(nxt);
            if constexpr (SP2) {
            PG8_LDB(B0, 0, 0); PG8_LDB(B1, 0, 1); PG8_SCHED; PG8_LDA(At, 0, 0); PG8_STAGE_X(PG8_SA(1, 1), a1 + hstep, voffA, AUX_A);
            PG8_WAIT_V(8); PG8_WAIT_L(0); PG8_BAR; PG8_MMA(0, 0, At, B0); PG8_MMA(0, 1, At, B1); PG8_BAR; PG8_SCHED;
            PG8_LDA(At, 0, 1); PG8_STAGE_X(PG8_SB(0, 0), b2, voffB, 0); PG8_STAGE_X(PG8_SB(0, 1), b2 + bhs, voffB, 0); PG8_STAGE_X(PG8_SA(0, 0), a2, voffA, AUX_A);
            PG8_WAIT_V(8); PG8_WAIT_L(0); PG8_BAR; PG8_MMA(1, 0, At, B0); PG8_MMA(1, 1, At, B1); PG8_BAR; PG8_SCHED;
            PG8_LDB(B0, 1, 0); PG8_LDB(B1, 1, 1); PG8_SCHED; PG8_LDA(At, 1, 0); PG8_STAGE_X(PG8_SA(0, 1), a2 + hstep, voffA, AUX_A);
            PG8_WAIT_V(8); PG8_WAIT_L(0); PG8_BAR; PG8_MMA(0, 0, At, B0); PG8_MMA(0, 1, At, B1); PG8_BAR; PG8_SCHED;
            PG8_LDA(At, 1, 1); PG8_STAGE_X(PG8_SB(1, 0), b3, voffB, 0); PG8_STAGE_X(PG8_SB(1, 1), b3 + bhs, voffB, 0); PG8_STAGE_X(PG8_SA(1, 0), a3, voffA, AUX_A);
            PG8_WAIT_V(8); PG8_WAIT_L(0); PG8_BAR; PG8_MMA(1, 0, At, B0); PG8_MMA(1, 1, At, B1); PG8_BAR; PG8_SCHED;
            } else {
            PG8_LDB(B0, 0, 0); PG8_SCHED; PG8_LDA(At, 0, 0); PG8_STAGE_X(PG8_SA(1, 1), a1 + hstep, voffA, AUX_A);
            PG8_WAIT_L(8); PG8_BAR; PG8_WAIT_L(0); PG8_MMA(0, 0, At, B0); PG8_BAR; PG8_SCHED;
            PG8_LDB(B1, 0, 1); PG8_STAGE_X(PG8_SB(0, 0), b2, voffB, 0);
            PG8_BAR; PG8_WAIT_L(0); PG8_MMA(0, 1, At, B1); PG8_BAR;
            PG8_LDA(At, 0, 1); PG8_STAGE_X(PG8_SA(0, 0), a2, voffA, AUX_A);
            PG8_BAR; PG8_WAIT_L(0); PG8_MMA(1, 0, At, B0); PG8_BAR; PG8_SCHED;
            PG8_STAGE_X(PG8_SB(0, 1), b2 + bhs, voffB, 0);
            PG8_WAIT_V(6); PG8_BAR; PG8_MMA(1, 1, At, B1); PG8_BAR;
            PG8_LDB(B0, 1, 0); PG8_SCHED; PG8_LDA(At, 1, 0); PG8_STAGE_X(PG8_SA(0, 1), a2 + hstep, voffA, AUX_A);
            PG8_WAIT_L(8); PG8_BAR; PG8_WAIT_L(0); PG8_MMA(0, 0, At, B0); PG8_BAR; PG8_SCHED;
            PG8_LDB(B1, 1, 1); PG8_STAGE_X(PG8_SB(1, 0), b3, voffB, 0);
            PG8_BAR; PG8_WAIT_L(0); PG8_MMA(0, 1, At, B1); PG8_BAR;
            PG8_LDA(At, 1, 1); PG8_STAGE_X(PG8_SA(1, 0), a3, voffA, AUX_A);
            PG8_BAR; PG8_WAIT_L(0); PG8_MMA(1, 0, At, B0); PG8_BAR; PG8_SCHED;
            PG8_STAGE_X(PG8_SB(1, 1), b3 + bhs, voffB, 0);
            PG8_WAIT_V(6); PG8_BAR; PG8_MMA(1, 1, At, B1); PG8_BAR;
            }
        }
        if constexpr (ALIGN_EPI) { if (wr == 0) PG8_BAR; }
        if constexpr (!Epi::AFTER_DRAIN) { E(acc, cur, wr, wc, fr, fq); S.done(cur); }
        if (!has_next) break;
#pragma unroll
        for (int a = 0; a < 2; ++a)
#pragma unroll
            for (int b = 0; b < 2; ++b)
#pragma unroll
                for (int m = 0; m < 4; ++m)
#pragma unroll
                    for (int n = 0; n < 2; ++n) acc[a][b][m][n] = (f32x4){0.f, 0.f, 0.f, 0.f};
        cur = nxt; cA = nA; cB = nB; ++ui;
        if constexpr (ALIGN_EPI) { if (wr == 1) PG8_BAR; }
    }
    PG8_WAIT_V(0);
    if constexpr (!ALIGN_EPI) { if (wr == 0) PG8_BAR; }
    PG8_BAR;
    if constexpr (Epi::AFTER_DRAIN) { E.fused(acc, cur, wr, wc, fr, fq, lds, wid, lane); S.done(cur); }
#undef PG8_SA
#undef PG8_SB
#undef PG8_STAGE_X
#undef PG8_LDA
#undef PG8_LDB
#undef PG8_MMA
#undef PG8_WAIT_V
#undef PG8_WAIT_L
#undef PG8_BAR
#undef PG8_SCHED
}
}
#define GAS __attribute__((address_space(1)))
#define LAS __attribute__((address_space(3)))
typedef unsigned short bf16;
typedef unsigned v4u __attribute__((ext_vector_type(4)));
typedef float f32x4 __attribute__((ext_vector_type(4)));
typedef short bf16x8 __attribute__((ext_vector_type(8)));
typedef GAS unsigned gu32;
typedef GAS unsigned long long gu64;
#define RLX_AGENT __ATOMIC_RELAXED, __HIP_MEMORY_SCOPE_AGENT
#define LDS_WAIT() asm volatile("s_waitcnt lgkmcnt(0)" ::: "memory")
#define VM_WAIT() asm volatile("s_waitcnt vmcnt(0)" ::: "memory")
__device__ __forceinline__ unsigned long long rt() { return __builtin_amdgcn_s_memrealtime(); }
__device__ __forceinline__ unsigned f2bf(float f) { unsigned u = __builtin_bit_cast(unsigned, f); return (u + 0x7fffu + ((u >> 16) & 1u)) >> 16; }
__device__ __forceinline__ unsigned pk2(float lo, float hi) { return f2bf(lo) | (f2bf(hi) << 16); }

#define XB_TMO      128
#define XB_XCNT(j)  (256  + 64 * (j))
#define XB_XSUB(j)  (1280 + 64 * (j))
#define XB_XGEN(j)  (2304 + 64 * (j))
#define XB_TOP      3328
#define XB_TOPGEN   3392
#define XCD_BAR_WORDS 3456
#define XB_SPIN_CAP (1u << 18)

__device__ __forceinline__ unsigned xb_ld(unsigned* p)              { return __hip_atomic_load(p, __ATOMIC_RELAXED, __HIP_MEMORY_SCOPE_AGENT); }
__device__ __forceinline__ unsigned xb_add(unsigned* p, unsigned v) { return __hip_atomic_fetch_add(p, v, __ATOMIC_RELAXED, __HIP_MEMORY_SCOPE_AGENT); }
__device__ __forceinline__ unsigned xb_xcc_id() { return (unsigned)__builtin_amdgcn_s_getreg((3 << 11) | 20) & 0xFu; }
#define XB_SPIN(cond, bar) do { unsigned _sp = 0; while (cond) { __builtin_amdgcn_s_sleep(1); \
    if ((++_sp & 255u) == 0u) { if (xb_ld(&(bar)[XB_TMO])) break; if (_sp > XB_SPIN_CAP) { atomicAdd(&(bar)[XB_TMO], 1u); break; } } } } while (0)

struct XcdBarrier {
    unsigned* bar; unsigned x;
    volatile LAS unsigned* st;
};

__device__ __forceinline__ XcdBarrier xcd_barrier_post(unsigned* bar, volatile LAS unsigned* st) {
    XcdBarrier b; b.bar = bar; b.x = xb_xcc_id(); b.st = st;
    if (threadIdx.x == 0) (void)xb_add(&bar[XB_XCNT(b.x)], 1u);
    return b;
}
__device__ __forceinline__ void xcd_barrier_complete(unsigned* bar, unsigned x, unsigned& nloc, unsigned& nx) {
    const unsigned G = gridDim.x * gridDim.y * gridDim.z;
    unsigned sum, cnt, mine, sp = 0u;
    for (;;) {
        sum = 0u; cnt = 0u; mine = 0u;
#pragma unroll
        for (unsigned j = 0; j < 16; ++j) { const unsigned c = xb_ld(&bar[XB_XCNT(j)]); sum += c; cnt += (c > 0u) ? 1u : 0u; mine = (j == x) ? c : mine; }
        if (sum == G) break;
        __builtin_amdgcn_s_sleep(1);
        if ((++sp & 255u) == 0u) { if (xb_ld(&bar[XB_TMO])) break; if (sp > XB_SPIN_CAP) { atomicAdd(&bar[XB_TMO], 1u); break; } }
    }
    nloc = mine > 0u ? mine : 1u; nx = cnt > 0u ? cnt : 1u;
}

__device__ __forceinline__ void xcd_barrier(const XcdBarrier& b) {
    asm volatile("s_waitcnt vmcnt(0)" ::: "memory");
    __syncthreads();
    if (threadIdx.x == 0) {
        unsigned* bar = b.bar;
        __builtin_amdgcn_s_waitcnt(0);
        unsigned nloc = b.st[0], nx = b.st[1];
        if (nloc == 0u) { xcd_barrier_complete(bar, b.x, nloc, nx); b.st[0] = nloc; b.st[1] = nx; }
        const unsigned old = xb_add(&bar[XB_XSUB(b.x)], 1u);
        const unsigned gen = old / nloc;
        if (old + 1u == (gen + 1u) * nloc) {
            __builtin_amdgcn_fence(__ATOMIC_RELEASE, "agent");
            asm volatile("s_waitcnt vmcnt(0)" ::: "memory");
            const unsigned og = xb_add(&bar[XB_TOP], 1u);
            const unsigned tg = og / nx;
            if (og + 1u == (tg + 1u) * nx) xb_add(&bar[XB_TOPGEN], 1u);
            else XB_SPIN(xb_ld(&bar[XB_TOPGEN]) == tg, bar);
            __builtin_amdgcn_fence(__ATOMIC_ACQUIRE, "agent");
            xb_add(&bar[XB_XGEN(b.x)], 1u);
            asm volatile("s_waitcnt vmcnt(0)" ::: "memory");
        } else {
            XB_SPIN(xb_ld(&bar[XB_XGEN(b.x)]) == gen, bar);
            __builtin_amdgcn_fence(__ATOMIC_ACQUIRE, "agent");
            asm volatile("s_waitcnt vmcnt(0)" ::: "memory");
        }
    }
    __syncthreads();
}
constexpr int NWAVES = 8;
constexpr int DM = 2048, DFF = 5632, NFF2 = 2 * DFF, NTOK = 24576, INW = 6144, DEPTH = 4, NIN = 22;
constexpr int S_PROMPT = 8192, S_SAMPLE = 4096;
constexpr float ALPHA = 1.6817928305074290f;
constexpr float LN_EPS = 1e-5f, RMS_EPS = 1e-6f;
constexpr size_t MiB = 1u << 20;
constexpr size_t WS_CTL = 0, WS_VEC = 1 * MiB, CTL_ZERO_BYTES = 2 * MiB;
constexpr int V_CS1 = 0, V_BW1 = NFF2, V_CSIN = 2 * NFF2, V_BWIN = V_CSIN + INW, V_CS2 = V_BWIN + INW, V_BW2 = V_CS2 + NFF2, V_LAYER = V_BW2 + NFF2;
static_assert((size_t)DEPTH * V_LAYER * 4 <= 1 * MiB, "vec");
constexpr size_t WS_ST = 2 * MiB;
constexpr size_t WS_ID = WS_ST + (size_t)2 * NTOK * 2 * 8;
static_assert(WS_ID + 2 * DM * 4 <= 4 * MiB, "st");
constexpr size_t SZ_W1 = (size_t)NFF2 * DM * 2, SZ_WD = (size_t)DM * DFF * 2, SZ_WIN = (size_t)INW * DM * 2, SZ_WOUT = (size_t)DM * DM * 2;
constexpr size_t OFF_W1A = 0, OFF_WD1 = OFF_W1A + SZ_W1, OFF_WIN = OFF_WD1 + SZ_WD, OFF_WOUT = OFF_WIN + SZ_WIN, OFF_W2A = OFF_WOUT + SZ_WOUT, OFF_WD2 = OFF_W2A + SZ_W1;
constexpr size_t SZ_LAYER = OFF_WD2 + SZ_WD;
constexpr size_t WS_W = 4 * MiB;
constexpr size_t SZ_XN = (size_t)NTOK * DM * 2;
constexpr size_t WS_XN = WS_W + DEPTH * SZ_LAYER;
constexpr size_t WS_Y = WS_XN + SZ_XN;
constexpr size_t WS_QKV = WS_Y + SZ_XN;
constexpr size_t SZ_QKV = (size_t)NTOK * INW * 2;
constexpr size_t WS_OA = WS_QKV + SZ_QKV;
constexpr size_t SZ_OA1 = (size_t)NTOK * 1024 * 2;
constexpr size_t WS_LSE = WS_OA + 3 * SZ_OA1;
constexpr size_t SZ_LSE1 = (size_t)NTOK * 8 * 4;
constexpr size_t WS_YL = WS_LSE + 3 * SZ_LSE1;
constexpr size_t WS_END = WS_YL + SZ_XN / 2;
constexpr int CW_TMO = 0, CW_CODE = 1, CW_BAR = 4096;
constexpr int CW_KN = 8192;
constexpr int CW_QH = 16384;
static_assert((CW_BAR + XCD_BAR_WORDS) * 4 <= (int)CTL_ZERO_BYTES, "ctl");
constexpr int RING_OFF = 0, RING_BYTES = 131072;
constexpr int LDSCTL_OFF = RING_BYTES, MISC_OFF = LDSCTL_OFF + 320;
constexpr int LDS_BYTES = 147456;
constexpr int KNL_OFF = LDSCTL_OFF + 1024;
constexpr int PH_PER_LAYER = 8, N_PHASES = 2 + DEPTH * PH_PER_LAYER;

struct Frame {
    LAS unsigned char* lds;
    volatile LAS unsigned* MISC;
    gu32* ctl;
    int wave, vcu, G;
};
__device__ __forceinline__ int ftid() { int t = threadIdx.x; asm volatile("" : "+v"(t)); return t; }
__device__ __forceinline__ int flane() { return ftid() & 63; }
__device__ __forceinline__ float wave_sum(float v) {
#pragma unroll
    for (int o = 1; o < 64; o <<= 1) v += __shfl_xor(v, o);
    return v;
}
__device__ __forceinline__ float bf2f(bf16 v) { return __uint_as_float((unsigned)v << 16); }
__device__ __forceinline__ void seq_of(int tok, int& base, int& S) { if (tok < S_PROMPT) { base = 0; S = S_PROMPT; } else { base = S_PROMPT + (((tok - S_PROMPT) >> 12) << 12); S = S_SAMPLE; } }

__device__ const unsigned short B_UNITS[1792] = {1536,1537,1538,1539,1540,1541,1542,1543,1544,1545,1546,1547,1548,1549,1550,1551,1552,1553,1554,1555,1556,1557,1558,1559,1560,1561,1562,1563,1564,1565,1566,1567,13568,13569,13570,28672,13571,13572,13573,28673,13574,13575,13576,28674,13577,13578,13579,28675,13580,13581,13582,28676,13583,13584,13585,28677,13586,13587,13588,28678,13589,13590,13591,28679,13592,13593,13594,28680,13595,13596,13597,28681,13598,13599,5120,28682,5121,5122,5123,28683,5124,5125,5126,28684,5127,5128,5129,28685,5130,5131,5132,28686,5133,5134,5135,28687,5136,5137,5138,28688,5139,5140,5141,28689,5142,5143,5144,28690,5145,5146,5147,28691,5148,5149,5150,28692,5151,4608,4609,28693,4610,4611,4612,28694,4613,4614,4615,28695,4616,4617,4618,28696,4619,4620,4621,28697,4622,4623,4624,28698,4625,4626,4627,28699,4628,4629,4630,28700,4631,4632,4633,28701,4634,4635,4636,28702,4637,4638,4639,28703,0,1,2,3,4,5,6,7,8,9,10,11,12,13,14,15,16,17,18,19,20,21,22,23,24,25,26,27,28,29,30,31,1568,1569,1570,1571,1572,1573,1574,1575,1576,1577,1578,1579,1580,1581,1582,1583,1584,1585,1586,1587,1588,1589,1590,1591,1592,1593,1594,1595,1596,1597,1598,1599,13824,13825,13826,28704,13827,13828,13829,28705,13830,13831,13832,28706,13833,13834,13835,28707,13836,13837,13838,28708,13839,13840,13841,28709,13842,13843,13844,28710,13845,13846,13847,28711,13848,13849,13850,28712,13851,13852,13853,28713,13854,13855,9216,28714,9217,9218,9219,28715,9220,9221,9222,28716,9223,9224,9225,28717,9226,9227,9228,28718,9229,9230,9231,28719,9232,9233,9234,28720,9235,9236,9237,28721,9238,9239,9240,28722,9241,9242,9243,28723,9244,9245,9246,28724,9247,8704,8705,28725,8706,8707,8708,28726,8709,8710,8711,28727,8712,8713,8714,28728,8715,8716,8717,28729,8718,8719,8720,28730,8721,8722,8723,28731,8724,8725,8726,28732,8727,8728,8729,28733,8730,8731,8732,28734,8733,8734,8735,28735,32,33,34,35,36,37,38,39,40,41,42,43,44,45,46,47,48,49,50,51,52,53,54,55,56,57,58,59,60,61,62,63,1792,1793,1794,1795,1796,1797,1798,1799,1800,1801,1802,1803,1804,1805,1806,1807,1808,1809,1810,1811,1812,1813,1814,1815,1816,1817,1818,1819,1820,1821,1822,1823,14080,14081,14082,28736,14083,14084,14085,28737,14086,14087,14088,28738,14089,14090,14091,28739,14092,14093,14094,28740,14095,14096,14097,28741,14098,14099,14100,28742,14101,14102,14103,28743,14104,14105,14106,28744,14107,14108,14109,28745,14110,14111,13312,28746,13313,13314,13315,28747,13316,13317,13318,28748,13319,13320,13321,28749,13322,13323,13324,28750,13325,13326,13327,28751,13328,13329,13330,28752,13331,13332,13333,28753,13334,13335,13336,28754,13337,13338,13339,28755,13340,13341,13342,28756,13343,12800,12801,28757,12802,12803,12804,28758,12805,12806,12807,28759,12808,12809,12810,28760,12811,12812,12813,28761,12814,12815,12816,28762,12817,12818,12819,28763,12820,12821,12822,28764,12823,12824,12825,28765,12826,12827,12828,28766,12829,12830,12831,28767,4096,4097,4098,4099,4100,4101,4102,4103,4104,4105,4106,4107,4108,4109,4110,4111,4112,4113,4114,4115,4116,4117,4118,4119,4120,4121,4122,4123,4124,4125,4126,4127,1824,1825,1826,1827,1828,1829,1830,1831,1832,1833,1834,1835,1836,1837,1838,1839,1840,1841,1842,1843,1844,1845,1846,1847,1848,1849,1850,1851,1852,1853,1854,1855,17664,17665,17666,28768,17667,17668,17669,28769,17670,17671,17672,28770,17673,17674,17675,28771,17676,17677,17678,28772,17679,17680,17681,28773,17682,17683,17684,28774,17685,17686,17687,28775,17688,17689,17690,28776,17691,17692,17693,28777,17694,17695,17408,28778,17409,17410,17411,28779,17412,17413,17414,28780,17415,17416,17417,28781,17418,17419,17420,28782,17421,17422,17423,28783,17424,17425,17426,28784,17427,17428,17429,28785,17430,17431,17432,28786,17433,17434,17435,28787,17436,17437,17438,28788,17439,16896,16897,28789,16898,16899,16900,28790,16901,16902,16903,28791,16904,16905,16906,28792,16907,16908,16909,28793,16910,16911,16912,28794,16913,16914,16915,28795,16916,16917,16918,28796,16919,16920,16921,28797,16922,16923,16924,28798,16925,16926,16927,28799,8192,8193,8194,8195,8196,8197,8198,8199,8200,8201,8202,8203,8204,8205,8206,8207,8208,8209,8210,8211,8212,8213,8214,8215,8216,8217,8218,8219,8220,8221,8222,8223,1280,1281,1282,1283,1284,1285,1286,1287,1288,1289,1290,1291,1292,1293,1294,1295,1296,1297,1298,1299,1300,1301,1302,1303,1304,1305,1306,1307,1308,1309,1310,1311,9728,9729,9730,28800,9731,9732,9733,28801,9734,9735,9736,28802,9737,9738,9739,28803,9740,9741,9742,28804,9743,9744,9745,28805,9746,9747,9748,28806,9749,9750,9751,28807,9752,9753,9754,28808,9755,9756,9757,28809,9758,9759,1024,28810,1025,1026,1027,28811,1028,1029,1030,28812,1031,1032,1033,28813,1034,1035,1036,28814,1037,1038,1039,28815,1040,1041,1042,28816,1043,1044,1045,28817,1046,1047,1048,28818,1049,1050,1051,28819,1052,1053,1054,28820,1055,4864,4865,28821,4866,4867,4868,28822,4869,4870,4871,28823,4872,4873,4874,28824,4875,4876,4877,28825,4878,4879,4880,28826,4881,4882,4883,28827,4884,4885,4886,28828,4887,4888,4889,28829,4890,4891,4892,28830,4893,4894,4895,28831,512,513,514,515,516,517,518,519,520,521,522,523,524,525,526,527,528,529,530,531,532,533,534,535,536,537,538,539,540,541,542,543,256,257,258,259,260,261,262,263,264,265,266,267,268,269,270,271,272,273,274,275,276,277,278,279,280,281,282,283,284,285,286,287,12544,12545,12546,12547,12548,12549,12550,12551,12552,12553,12554,12555,12556,12557,12558,12559,12560,12561,12562,12563,12564,12565,12566,12567,12568,12569,12570,12571,12572,12573,12574,12575,1312,1313,1314,1315,1316,1317,1318,1319,1320,1321,1322,1323,1324,1325,1326,1327,1328,1329,1330,1331,1332,1333,1334,1335,1336,1337,1338,1339,1340,1341,1342,1343,9984,9985,9986,28832,9987,9988,9989,28833,9990,9991,9992,28834,9993,9994,9995,28835,9996,9997,9998,28836,9999,10000,10001,28837,10002,10003,10004,28838,10005,10006,10007,28839,10008,10009,10010,28840,10011,10012,10013,28841,10014,10015,1056,28842,1057,1058,1059,28843,1060,1061,1062,28844,1063,1064,1065,28845,1066,1067,1068,28846,1069,1070,1071,28847,1072,1073,1074,28848,1075,1076,1077,28849,1078,1079,1080,28850,1081,1082,1083,28851,1084,1085,1086,28852,1087,8960,8961,28853,8962,8963,8964,28854,8965,8966,8967,28855,8968,8969,8970,28856,8971,8972,8973,28857,8974,8975,8976,28858,8977,8978,8979,28859,8980,8981,8982,28860,8983,8984,8985,28861,8986,8987,8988,28862,8989,8990,8991,28863,544,545,546,547,548,549,550,551,552,553,554,555,556,557,558,559,560,561,562,563,564,565,566,567,568,569,570,571,572,573,574,575,288,289,290,291,292,293,294,295,296,297,298,299,300,301,302,303,304,305,306,307,308,309,310,311,312,313,314,315,316,317,318,319,16640,16641,16642,16643,16644,16645,16646,16647,16648,16649,16650,16651,16652,16653,16654,16655,16656,16657,16658,16659,16660,16661,16662,16663,16664,16665,16666,16667,16668,16669,16670,16671,5376,5377,5378,5379,5380,5381,5382,5383,5384,5385,5386,5387,5388,5389,5390,5391,5392,5393,5394,5395,5396,5397,5398,5399,5400,5401,5402,5403,5404,5405,5406,5407,5888,5889,5890,28864,5891,5892,5893,28865,5894,5895,5896,28866,5897,5898,5899,28867,5900,5901,5902,28868,5903,5904,5905,28869,5906,5907,5908,28870,5909,5910,5911,28871,5912,5913,5914,28872,5915,5916,5917,28873,5918,5919,17920,28874,17921,17922,17923,28875,17924,17925,17926,28876,17927,17928,17929,28877,17930,17931,17932,28878,17933,17934,17935,28879,17936,17937,17938,28880,17939,17940,17941,28881,17942,17943,17944,28882,17945,17946,17947,28883,17948,17949,17950,28884,17951,768,769,28885,770,771,772,28886,773,774,775,28887,776,777,778,28888,779,780,781,28889,782,783,784,28890,785,786,787,28891,788,789,790,28892,791,792,793,28893,794,795,796,28894,797,798,799,28895,13056,13057,13058,13059,13060,13061,13062,13063,13064,13065,13066,13067,13068,13069,13070,13071,13072,13073,13074,13075,13076,13077,13078,13079,13080,13081,13082,13083,13084,13085,13086,13087,4352,4353,4354,4355,4356,4357,4358,4359,4360,4361,4362,4363,4364,4365,4366,4367,4368,4369,4370,4371,4372,4373,4374,4375,4376,4377,4378,4379,4380,4381,4382,4383,12288,12289,12290,12291,12292,12293,12294,12295,12296,12297,12298,12299,12300,12301,12302,12303,12304,12305,12306,12307,12308,12309,12310,12311,12312,12313,12314,12315,12316,12317,12318,12319,5632,5633,5634,5635,5636,5637,5638,5639,5640,5641,5642,5643,5644,5645,5646,5647,5648,5649,5650,5651,5652,5653,5654,5655,5656,5657,5658,5659,5660,5661,5662,5663,9472,9473,9474,28896,9475,9476,9477,28897,9478,9479,9480,28898,9481,9482,9483,28899,9484,9485,9486,28900,9487,9488,9489,28901,9490,9491,9492,28902,9493,9494,9495,28903,9496,9497,9498,28904,9499,9500,9501,28905,9502,9503,18176,28906,18177,18178,18179,28907,18180,18181,18182,28908,18183,18184,18185,28909,18186,18187,18188,28910,18189,18190,18191,28911,18192,18193,18194,28912,18195,18196,18197,28913,18198,18199,18200,28914,18201,18202,18203,28915,18204,18205,18206,28916,18207,800,801,28917,802,803,804,28918,805,806,807,28919,808,809,810,28920,811,812,813,28921,814,815,816,28922,817,818,819,28923,820,821,822,28924,823,824,825,28925,826,827,828,28926,829,830,831,28927,17152,17153,17154,17155,17156,17157,17158,17159,17160,17161,17162,17163,17164,17165,17166,17167,17168,17169,17170,17171,17172,17173,17174,17175,17176,17177,17178,17179,17180,17181,17182,17183,8448,8449,8450,8451,8452,8453,8454,8455,8456,8457,8458,8459,8460,8461,8462,8463,8464,8465,8466,8467,8468,8469,8470,8471,8472,8473,8474,8475,8476,8477,8478,8479,16384,16385,16386,16387,16388,16389,16390,16391,16392,16393,16394,16395,16396,16397,16398,16399,16400,16401,16402,16403,16404,16405,16406,16407,16408,16409,16410,16411,16412,16413,16414,16415};
__device__ const int B_CHUNK[9] = {0,192,384,576,768,1024,1280,1536,1792};
namespace att {
using s16x4  = __attribute__((ext_vector_type(4))) short;
using f32x16 = __attribute__((ext_vector_type(16))) float;
using u32x4  = __attribute__((ext_vector_type(4))) unsigned;
constexpr int HD = 128;
__device__ __forceinline__ const bf16* secp(const bf16* QKV, int sec, int h) { return QKV + (size_t)(sec * 8 + h) * NTOK * HD; }
constexpr int SHM_V = 64 * 128 * 2, SHM_K = 64 * 128 * 2;
constexpr int LDS_WSF = 2 * SHM_V + 2 * SHM_K;
constexpr int ATT_LDS_BYTES = LDS_WSF + 8 * 64 * 4;
constexpr int B_LDS_WSF = 131072 + 4096;
constexpr float LOG2E = 1.4426950408889634f;
#define KSWZ(row, colB) ((row) * 256 + ((colB) ^ (((row) & 7) << 4)))
#define SBAR() __builtin_amdgcn_sched_barrier(0)
__device__ __forceinline__ int crow(int r, int hi) { return (r & 3) + 8 * (r >> 2) + 4 * hi; }
__device__ __forceinline__ unsigned cvtpk(float lo, float hi) { unsigned r; asm volatile("v_cvt_pk_bf16_f32 %0, %1, %2" : "=v"(r) : "v"(lo), "v"(hi)); return r; }
__device__ __forceinline__ int v_st(int k, int c) { const int kk = k;   return ((kk >> 3) * 4 + (c >> 5)) * 512 + ((kk & 7) * 32 + (c & 31)) * 2; }
__device__ __forceinline__ int v_rd_base(int lane) { return ((lane & 3) << 3) | (((lane >> 2) & 3) << 6) | (((lane >> 4) & 1) << 5) | (((lane >> 5) & 1) << 8); }
constexpr int v_rd_off(int d0, int ks, int half) { return d0 * 512 + ks * 4096 + half * 2048; }
template <int OFF> __device__ __forceinline__ s16x4 tr_read(int vb) { s16x4 r; asm volatile("ds_read_b64_tr_b16 %0, %1 offset:%2" : "=&v"(r) : "v"(vb), "i"(OFF) : "memory"); return r; }
template <int D0> __device__ __forceinline__ void pv_one(f32x16& od, int vb, bf16x8 pa0, bf16x8 pa1, bf16x8 pa2, bf16x8 pa3) {
  const s16x4 l0 = tr_read<v_rd_off(D0, 0, 0)>(vb), h0 = tr_read<v_rd_off(D0, 0, 1)>(vb), l1 = tr_read<v_rd_off(D0, 1, 0)>(vb), h1 = tr_read<v_rd_off(D0, 1, 1)>(vb);
  const s16x4 l2 = tr_read<v_rd_off(D0, 2, 0)>(vb), h2 = tr_read<v_rd_off(D0, 2, 1)>(vb), l3 = tr_read<v_rd_off(D0, 3, 0)>(vb), h3 = tr_read<v_rd_off(D0, 3, 1)>(vb);
  asm volatile("s_waitcnt lgkmcnt(0)" ::: "memory"); SBAR();
#define PK(L, H) (bf16x8){L[0], L[1], L[2], L[3], H[0], H[1], H[2], H[3]}
  od = __builtin_amdgcn_mfma_f32_32x32x16_bf16(pa0, PK(l0, h0), od, 0, 0, 0);
  od = __builtin_amdgcn_mfma_f32_32x32x16_bf16(pa1, PK(l1, h1), od, 0, 0, 0);
  od = __builtin_amdgcn_mfma_f32_32x32x16_bf16(pa2, PK(l2, h2), od, 0, 0, 0);
  od = __builtin_amdgcn_mfma_f32_32x32x16_bf16(pa3, PK(l3, h3), od, 0, 0, 0);
#undef PK
}
struct VFrag { s16x4 l0, h0, l1, h1, l2, h2, l3, h3; };
template <int D0> __device__ __forceinline__ void vfrag_read(VFrag& F, int vb) {
  F.l0 = tr_read<v_rd_off(D0, 0, 0)>(vb); F.h0 = tr_read<v_rd_off(D0, 0, 1)>(vb); F.l1 = tr_read<v_rd_off(D0, 1, 0)>(vb); F.h1 = tr_read<v_rd_off(D0, 1, 1)>(vb);
  F.l2 = tr_read<v_rd_off(D0, 2, 0)>(vb); F.h2 = tr_read<v_rd_off(D0, 2, 1)>(vb); F.l3 = tr_read<v_rd_off(D0, 3, 0)>(vb); F.h3 = tr_read<v_rd_off(D0, 3, 1)>(vb);
}
__device__ __forceinline__ void vfrag_mma(f32x16& od, const VFrag& F, bf16x8 pa0, bf16x8 pa1, bf16x8 pa2, bf16x8 pa3) {
#define PK(L, H) (bf16x8){L[0], L[1], L[2], L[3], H[0], H[1], H[2], H[3]}
  od = __builtin_amdgcn_mfma_f32_32x32x16_bf16(pa0, PK(F.l0, F.h0), od, 0, 0, 0); od = __builtin_amdgcn_mfma_f32_32x32x16_bf16(pa1, PK(F.l1, F.h1), od, 0, 0, 0);
  od = __builtin_amdgcn_mfma_f32_32x32x16_bf16(pa2, PK(F.l2, F.h2), od, 0, 0, 0); od = __builtin_amdgcn_mfma_f32_32x32x16_bf16(pa3, PK(F.l3, F.h3), od, 0, 0, 0);
#undef PK
}
__device__ __forceinline__ void pv_d0(f32x16* o, int vb, bf16x8 pa0, bf16x8 pa1, bf16x8 pa2, bf16x8 pa3) {
  VFrag fA, fB;
  SBAR(); vfrag_read<0>(fA, vb); vfrag_read<1>(fB, vb); asm volatile("s_waitcnt lgkmcnt(8)" ::: "memory"); SBAR(); vfrag_mma(o[0], fA, pa0, pa1, pa2, pa3);
  SBAR(); vfrag_read<2>(fA, vb); asm volatile("s_waitcnt lgkmcnt(8)" ::: "memory"); SBAR(); vfrag_mma(o[1], fB, pa0, pa1, pa2, pa3);
  SBAR(); vfrag_read<3>(fB, vb); asm volatile("s_waitcnt lgkmcnt(8)" ::: "memory"); SBAR(); vfrag_mma(o[2], fA, pa0, pa1, pa2, pa3);
  SBAR(); asm volatile("s_waitcnt lgkmcnt(0)" ::: "memory"); SBAR(); vfrag_mma(o[3], fB, pa0, pa1, pa2, pa3);
}
__device__ __forceinline__ void finishSM(f32x16& p0, f32x16& p1, float alpha, float& l_reg, bf16x8& pa0, bf16x8& pa1, bf16x8& pa2, bf16x8& pa3) {
#pragma unroll
  for (int r = 0; r < 16; ++r) p1[r] = __builtin_amdgcn_exp2f(p1[r]);
  float ps = 0;
#pragma unroll
  for (int r = 0; r < 16; ++r) ps += p0[r];
#pragma unroll
  for (int r = 0; r < 16; ++r) ps += p1[r];
  { auto rr = __builtin_amdgcn_permlane32_swap(__float_as_uint(ps), __float_as_uint(ps), false, false); ps = __uint_as_float(rr[0]) + __uint_as_float(rr[1]); }
  l_reg = l_reg * alpha + ps;
#define PK4(P, BASE, OUT) do { u32x4 w = {cvtpk(P[BASE + 0], P[BASE + 1]), cvtpk(P[BASE + 2], P[BASE + 3]), cvtpk(P[BASE + 4], P[BASE + 5]), cvtpk(P[BASE + 6], P[BASE + 7])}; OUT = *reinterpret_cast<bf16x8*>(&w); } while (0)
  PK4(p0, 0, pa0); PK4(p0, 8, pa1); PK4(p1, 0, pa2); PK4(p1, 8, pa3);
#undef PK4
}
template <int ND0> __device__ __forceinline__ void qkt(f32x16& p0, f32x16& p1, const char* Ks, const bf16x8* qr, int cb0, int r32, int hi) {
  p0 = f32x16{}; p1 = f32x16{};
#pragma unroll
  for (int d0 = 0; d0 < ND0; ++d0) { const int cb = cb0 + (d0 * 16 + hi * 8) * 2;
    const bf16x8 b0 = *reinterpret_cast<const bf16x8*>(Ks + KSWZ(r32, cb));
    const bf16x8 b1 = *reinterpret_cast<const bf16x8*>(Ks + KSWZ(32 + r32, cb));
    p0 = __builtin_amdgcn_mfma_f32_32x32x16_bf16(b0, qr[d0], p0, 0, 0, 0);
    p1 = __builtin_amdgcn_mfma_f32_32x32x16_bf16(b1, qr[d0], p1, 0, 0, 0); }
}
__device__ __forceinline__ float half_sum(float v) {
#pragma unroll
  for (int o = 1; o < 32; o <<= 1) v += __shfl_xor(v, o);
  return v;
}

constexpr float THR2 = 8.f * LOG2E;
__device__ __forceinline__ void partialSM_B(f32x16& p0, f32x16& p1, float& m_reg, float& mn, float& alpha, float dlt, float nslope) {
  constexpr float C = 0.125f * LOG2E;
#pragma unroll
  for (int r = 0; r < 16; ++r) { const float kc = (float)((r & 3) + 8 * (r >> 2));
    p0[r] = fmaf(p0[r], C, fabsf(dlt - kc) * nslope); p1[r] = fmaf(p1[r], C, fabsf(dlt - (kc + 32.f)) * nslope); }
  float pmax = p0[0];
#pragma unroll
  for (int r = 1; r < 16; ++r) pmax = fmaxf(pmax, p0[r]);
#pragma unroll
  for (int r = 0; r < 16; ++r) pmax = fmaxf(pmax, p1[r]);
  { auto rr = __builtin_amdgcn_permlane32_swap(__float_as_uint(pmax), __float_as_uint(pmax), false, false); pmax = fmaxf(__uint_as_float(rr[0]), __uint_as_float(rr[1])); }
  if (__builtin_expect(__all(pmax - m_reg <= THR2), 1)) { mn = m_reg; alpha = 1.f; }
  else { mn = fmaxf(m_reg, pmax); alpha = __builtin_amdgcn_exp2f(m_reg - mn); m_reg = mn; }
#pragma unroll
  for (int r = 0; r < 16; ++r) p0[r] = __builtin_amdgcn_exp2f(p0[r] - mn);
#pragma unroll
  for (int r = 0; r < 16; ++r) p1[r] -= mn;
}
__device__ __forceinline__ void partialSM_lin(f32x16& p0, f32x16& p1, float& m_reg, float& mn, float& alpha, float base, float sh) {
  constexpr float C = 0.125f * LOG2E;
  float pm0 = __builtin_fmaxf(__builtin_fmaxf(p0[0], p0[1]), p0[2]), pm1 = __builtin_fmaxf(__builtin_fmaxf(p1[0], p1[1]), p1[2]);
#pragma unroll
  for (int r = 3; r < 15; r += 2) { pm0 = __builtin_fmaxf(__builtin_fmaxf(pm0, p0[r]), p0[r + 1]); pm1 = __builtin_fmaxf(__builtin_fmaxf(pm1, p1[r]), p1[r + 1]); }
  pm0 = __builtin_fmaxf(pm0, p0[15]); pm1 = __builtin_fmaxf(pm1, p1[15]);
  float pmax = fmaxf(pm0, pm1 + sh);
  { auto rr = __builtin_amdgcn_permlane32_swap(__float_as_uint(pmax), __float_as_uint(pmax), false, false); pmax = fmaxf(__uint_as_float(rr[0]), __uint_as_float(rr[1])); }
  const float smax = fmaf(pmax, C, base);
  if (__builtin_expect(__all(smax - m_reg <= THR2), 1)) { mn = m_reg; alpha = 1.f; }
  else { mn = fmaxf(m_reg, smax); alpha = __builtin_amdgcn_exp2f(m_reg - mn); m_reg = mn; }
  const float off0 = base - mn, off1 = fmaf(sh, C, off0);
#pragma unroll
  for (int r = 0; r < 16; ++r) p0[r] = __builtin_amdgcn_exp2f(fmaf(p0[r], C, off0));
#pragma unroll
  for (int r = 0; r < 16; ++r) p1[r] = fmaf(p1[r], C, off1);
}
__device__ __forceinline__ void qkt_b(f32x16& p0, f32x16& p1, const char* Ks, const bf16x8* qr, int cb0, int r32, int hi, bf16x8 kext, bf16x8 qe) {
  bf16x8 b0[4], b1[4];
#pragma unroll
  for (int d0 = 0; d0 < 4; ++d0) { const int cb = cb0 + (d0 * 16 + hi * 8) * 2;
    b0[d0] = *reinterpret_cast<const bf16x8*>(Ks + KSWZ(r32, cb)); b1[d0] = *reinterpret_cast<const bf16x8*>(Ks + KSWZ(32 + r32, cb)); }
  SBAR();
  p0 = __builtin_amdgcn_mfma_f32_32x32x16_bf16(kext, qe, f32x16{}, 0, 0, 0);
  p1 = __builtin_amdgcn_mfma_f32_32x32x16_bf16(kext, qe, f32x16{}, 0, 0, 0);
#pragma unroll
  for (int d0 = 0; d0 < 4; ++d0) {
    p0 = __builtin_amdgcn_mfma_f32_32x32x16_bf16(b0[d0], qr[d0], p0, 0, 0, 0);
    p1 = __builtin_amdgcn_mfma_f32_32x32x16_bf16(b1[d0], qr[d0], p1, 0, 0, 0); }
}
template <int OFF> __device__ __forceinline__ bf16x8 lds_rd128(int addr) { bf16x8 r; asm volatile("ds_read_b128 %0, %1 offset:%2" : "=&v"(r) : "v"(addr), "i"(OFF) : "memory"); return r; }
__device__ __forceinline__ void qkt_frag(f32x16& p0, f32x16& p1, const bf16x8 (&b0)[4], const bf16x8 (&b1)[4], const bf16x8* qr, bf16x8 kext, bf16x8 qe) {
  p0 = __builtin_amdgcn_mfma_f32_32x32x16_bf16(kext, qe, f32x16{}, 0, 0, 0);
  p1 = p0;
  asm volatile("s_waitcnt lgkmcnt(8)" ::: "memory"); SBAR();
#pragma unroll
  for (int d0 = 0; d0 < 4; ++d0) {
    p0 = __builtin_amdgcn_mfma_f32_32x32x16_bf16(b0[d0], qr[d0], p0, 0, 0, 0);
    p1 = __builtin_amdgcn_mfma_f32_32x32x16_bf16(b1[d0], qr[d0], p1, 0, 0, 0); }
}
constexpr float THETA = 40.f;
__device__ __forceinline__ float bfx(short v) { return __uint_as_float(((unsigned)(unsigned short)v) << 16); }
__device__ __forceinline__ void attn_b_unit(const bf16* __restrict__ QKV, bf16* __restrict__ Y, int base, int S, int h, int q0, float lam, const float* __restrict__ subg, float outscale, const float* __restrict__ kn2p, char* lds) {
  int tid_ = threadIdx.x; asm volatile("" : "+v"(tid_));
  const int tid = tid_, wid = __builtin_amdgcn_readfirstlane(tid >> 6), lane = tid & 63, r32 = lane & 31, hi = lane >> 5, cmap = wid >> 2, wq = wid & 3;
  char* V_lds = lds; char* K_lds = lds + 4 * SHM_V;
  float* ws = (float*)(lds + B_LDS_WSF) + wid * 64; float* li_l = ws; float* al_l = ws + 32;
  float m_reg = -1e30f, l_reg = 0; f32x16 o[4] = {}; bf16x8 qr[4];
  const int qi = q0 + wq * 32 + r32;
  const bf16* Qw = secp(QKV, 3, h) + (size_t)(base + qi) * HD + cmap * 64 + hi * 8;
#pragma unroll
  for (int d0 = 0; d0 < 4; ++d0) qr[d0] = *reinterpret_cast<const bf16x8*>(Qw + d0 * 16);
  const bf16* Kh = secp(QKV, 4, h) + (size_t)base * HD; const bf16* Vh = secp(QKV, 5, h) + (size_t)base * HD;
  const int sr = tid >> 4, sc = (tid & 15) * 8, vst0 = v_st(sr, sc), vst1 = v_st(32 + sr, sc);
  const int vb0 = (int)(uintptr_t)V_lds + v_rd_base(lane);
  const int cb0 = cmap * 128;
  const float nslope = __uint_as_float(__builtin_amdgcn_readfirstlane(__float_as_uint(-LOG2E * __builtin_amdgcn_exp2f(-(float)(h + 1)))));
  int t_lo, NT;
  { float qn2 = 0.f, sdot = 0.f;
    const bf16* Kself = secp(QKV, 4, h) + (size_t)(base + qi) * HD + cmap * 64 + hi * 8;
    bf16x8 kvs[4];
#pragma unroll
    for (int d0 = 0; d0 < 4; ++d0) kvs[d0] = *reinterpret_cast<const bf16x8*>(Kself + d0 * 16);
    float kn2v = kn2p[cmap];
    asm volatile("" : "+v"(kvs[0]), "+v"(kvs[1]), "+v"(kvs[2]), "+v"(kvs[3]), "+v"(kn2v));
#pragma unroll
    for (int d0 = 0; d0 < 4; ++d0) {
#pragma unroll
      for (int e = 0; e < 8; ++e) { const float qf = bfx(qr[d0][e]), kf = bfx(kvs[d0][e]); qn2 = fmaf(qf, qf, qn2); sdot = fmaf(qf, kf, sdot); } }
    qn2 += __shfl_xor(qn2, 32); sdot += __shfl_xor(sdot, 32);
    constexpr float C = 0.125f * LOG2E;
    float Ri = (C * sqrtf(qn2 * kn2v) * 1.001f - C * sdot + THETA) / (-nslope);
#pragma unroll
    for (int o_ = 1; o_ < 32; o_ <<= 1) Ri = fmaxf(Ri, __shfl_xor(Ri, o_));
    float* rbuf = (float*)(lds + B_LDS_WSF + 8 * 64 * 4);
    if (lane == 0) rbuf[wid] = Ri;
    __syncthreads();
    float R = rbuf[0];
#pragma unroll
    for (int w_ = 1; w_ < 8; ++w_) R = fmaxf(R, rbuf[w_]);
    const int Rint = (int)fminf(fmaxf(R, 0.f), 1.0e6f) + 1, NTall = S / 64;
    int lo_ = q0 - Rint; lo_ = lo_ < 0 ? 0 : lo_; t_lo = lo_ >> 6;
    int t_hi = (q0 + 127 + Rint) >> 6; t_hi = t_hi > NTall - 1 ? NTall - 1 : t_hi;
    if (((t_hi - t_lo + 1) & 1) != 0) { if (t_hi < NTall - 1) ++t_hi; else --t_lo; }
    NT = t_hi - t_lo + 1;
    t_lo = __builtin_amdgcn_readfirstlane(t_lo); NT = __builtin_amdgcn_readfirstlane(NT);
  }
  const int kbase = t_lo * 64;
  const float di0 = (float)(qi - kbase);
  const int tdr = ((q0 + wq * 32) >> 6) - t_lo;
  const float s8 = __uint_as_float(__builtin_amdgcn_readfirstlane(__float_as_uint(__builtin_amdgcn_exp2f((float)(2 - h)))));
  const unsigned s8b = hi == 0 ? (__float_as_uint(s8) >> 16) : 0u;
  bf16x8 kext = {0, 0, 0, 0, 0, 0, 0, 0};
  if (hi == 0) kext[0] = (short)(__float_as_uint((float)r32) >> 16);
#define QKT(P0, P1, KS, idx) do { v4u qe_ = {s8b ^ (((idx) > tdr) ? 0x8000u : 0u), 0u, 0u, 0u}; qkt_b(P0, P1, KS, qr, cb0, r32, hi, kext, __builtin_bit_cast(bf16x8, qe_)); } while (0)
  int kofs[4];
#pragma unroll
  for (int d0 = 0; d0 < 4; ++d0) kofs[d0] = (int)(uintptr_t)K_lds + KSWZ(r32, cb0 + (d0 * 16 + hi * 8) * 2);
#define QKTF(P0, P1, B0, B1, idx) do { v4u qe_ = {s8b ^ (((idx) > tdr) ? 0x8000u : 0u), 0u, 0u, 0u}; qkt_frag(P0, P1, B0, B1, qr, kext, __builtin_bit_cast(bf16x8, qe_)); } while (0)
#define PSM(P0, P1, MN, AL, idx) do { const float dd_ = di0 - (float)((idx) * 64); \
    if ((idx) == tdr) { const float c2_ = -2.f * s8, dk_ = dd_ - (float)(4 * hi); \
      _Pragma("unroll") for (int r = 0; r < 16; ++r) { const float kc_ = (float)((r & 3) + 8 * (r >> 2)); P0[r] = fmaf(fmaxf(kc_ - dk_, 0.f), c2_, P0[r]); P1[r] = fmaf(fmaxf(kc_ + 32.f - dk_, 0.f), c2_, P1[r]); } } \
    partialSM_lin(P0, P1, m_reg, MN, AL, nslope * fabsf(dd_), ((idx) > tdr) ? -32.f * s8 : 32.f * s8); } while (0)
  const int wq4 = wid & 3;
  unsigned koff[2], voff[2];
#pragma unroll
  for (int i_ = 0; i_ < 2; ++i_) { const int b_ = 8192 * cmap + (wq4 * 2 + i_) * 1024 + lane * 16;
    const int row_ = b_ >> 8, pos_ = (b_ >> 4) & 15; koff[i_] = (unsigned)(row_ * 256 + ((pos_ ^ (row_ & 7)) << 4));
    const int sub_ = b_ >> 9, e_ = (b_ & 511) >> 1, kk_ = (sub_ >> 2) * 8 + (e_ >> 5), k_ = kk_;
    voff[i_] = (unsigned)(k_ * 256 + ((sub_ & 3) * 32 + (e_ & 31)) * 2); }
  const unsigned ldsK = (unsigned)(uintptr_t)K_lds + 8192u * cmap + 2048u * wq4, ldsV = (unsigned)(uintptr_t)V_lds + 8192u * cmap + 2048u * wq4;
#define SLOT(t) (((t) & 3) * SHM_V)
#define DMA_TILE(t) do { const char* kt_ = (const char*)Kh + (size_t)(kbase + (t) * 64) * 256; const char* vt_ = (const char*)Vh + (size_t)(kbase + (t) * 64) * 256; const unsigned so_ = SLOT(t); \
    _Pragma("unroll") for (int i_ = 0; i_ < 2; ++i_) { \
      __builtin_amdgcn_global_load_lds((const unsigned*)(kt_ + koff[i_]), (LAS unsigned*)(ldsK + so_ + i_ * 1024), 16, 0, 0); \
      __builtin_amdgcn_global_load_lds((const unsigned*)(vt_ + voff[i_]), (LAS unsigned*)(ldsV + so_ + i_ * 1024), 16, 0, 0); } } while (0)
#define RESC(a) do { if (__any((a) < 1.f)) { if (hi == 0) al_l[r32] = (a); asm volatile("s_waitcnt lgkmcnt(0)" ::: "memory"); \
    _Pragma("unroll") for (int d = 0; d < 4; ++d) _Pragma("unroll") for (int r = 0; r < 16; ++r) o[d][r] *= al_l[crow(r, hi)]; } } while (0)
#define BARM() do { SBAR(); asm volatile("s_waitcnt lgkmcnt(0)\n\ts_barrier" ::: "memory"); SBAR(); } while (0)
#define BARL(t) do { SBAR(); if ((t) < NT) asm volatile("s_waitcnt vmcnt(4) lgkmcnt(0)\n\ts_barrier" ::: "memory"); else asm volatile("s_waitcnt vmcnt(0) lgkmcnt(0)\n\ts_barrier" ::: "memory"); SBAR(); } while (0)
  struct VF { s16x4 l0, h0, l1, h1, l2, h2, l3, h3; };
#define TR8(F, VB, D0) do { F.l0 = tr_read<v_rd_off(D0, 0, 0)>(VB); F.h0 = tr_read<v_rd_off(D0, 0, 1)>(VB); F.l1 = tr_read<v_rd_off(D0, 1, 0)>(VB); F.h1 = tr_read<v_rd_off(D0, 1, 1)>(VB); \
    F.l2 = tr_read<v_rd_off(D0, 2, 0)>(VB); F.h2 = tr_read<v_rd_off(D0, 2, 1)>(VB); F.l3 = tr_read<v_rd_off(D0, 3, 0)>(VB); F.h3 = tr_read<v_rd_off(D0, 3, 1)>(VB); } while (0)
#define PKF(L, H) (bf16x8){L[0], L[1], L[2], L[3], H[0], H[1], H[2], H[3]}
#define MF4(OD, F) do { OD = __builtin_amdgcn_mfma_f32_32x32x16_bf16(pa0, PKF(F.l0, F.h0), OD, 0, 0, 0); OD = __builtin_amdgcn_mfma_f32_32x32x16_bf16(pa1, PKF(F.l1, F.h1), OD, 0, 0, 0); \
    OD = __builtin_amdgcn_mfma_f32_32x32x16_bf16(pa2, PKF(F.l2, F.h2), OD, 0, 0, 0); OD = __builtin_amdgcn_mfma_f32_32x32x16_bf16(pa3, PKF(F.l3, F.h3), OD, 0, 0, 0); } while (0)
#define WAITL(n) asm volatile("s_waitcnt lgkmcnt(" #n ")" ::: "memory")
#define MSEG(jj) do { const int vbp_ = vb0 + SLOT((jj) - 1), ks_ = SLOT(jj); VF fA_, fB_, fC_; bf16x8 kb0_[4], kb1_[4]; \
    SBAR(); _Pragma("unroll") for (int d0 = 0; d0 < 4; ++d0) { kb0_[d0] = lds_rd128<0>(kofs[d0] + ks_); kb1_[d0] = lds_rd128<8192>(kofs[d0] + ks_); } \
    TR8(fA_, vbp_, 0); SBAR(); QKTF(pC0, pC1, kb0_, kb1_, jj);   \
    SBAR(); TR8(fB_, vbp_, 1); WAITL(8); SBAR(); MF4(o[0], fA_); \
    SBAR(); TR8(fC_, vbp_, 2); WAITL(8); SBAR(); MF4(o[1], fB_); \
    SBAR(); TR8(fA_, vbp_, 3); WAITL(8); SBAR(); MF4(o[2], fC_); \
    SBAR(); WAITL(0); SBAR(); MF4(o[3], fA_); } while (0)
#define LSEG(jj) do { PSM(pC0, pC1, mnC, alC, jj); finishSM(pC0, pC1, alC, l_reg, pa0, pa1, pa2, pa3); RESC(alC); \
    const int tn_ = (jj) + 2 + cmap; if (tn_ < NT) DMA_TILE(tn_); BARL(tn_); } while (0)
  f32x16 pC0, pC1; float mnC = 0.f, alC = 1.f; bf16x8 pa0, pa1, pa2, pa3;
  DMA_TILE(0); DMA_TILE(1); if (cmap == 1 && 2 < NT) DMA_TILE(2);
  SBAR(); if (cmap == 1 && 2 < NT) asm volatile("s_waitcnt vmcnt(4) lgkmcnt(0)\n\ts_barrier" ::: "memory"); else asm volatile("s_waitcnt vmcnt(0) lgkmcnt(0)\n\ts_barrier" ::: "memory"); SBAR();
  if (cmap == 1) BARM();
  SBAR(); QKT(pC0, pC1, K_lds, 0); BARM(); LSEG(0);
  if (cmap == 1) __builtin_amdgcn_s_setprio(1);
  for (int j = 1; j < NT; ++j) { MSEG(j); BARM(); LSEG(j); }
  __builtin_amdgcn_s_setprio(0);
  { const int vbp_ = vb0 + SLOT(NT - 1); VF fA_, fB_, fC_;
    SBAR(); TR8(fA_, vbp_, 0); TR8(fB_, vbp_, 1); TR8(fC_, vbp_, 2); WAITL(8); SBAR(); MF4(o[0], fA_); MF4(o[1], fB_);
    SBAR(); TR8(fA_, vbp_, 3); WAITL(8); SBAR(); MF4(o[2], fC_);
    SBAR(); WAITL(0); SBAR(); MF4(o[3], fA_); }
  if (cmap == 0) BARM();
#undef SLOT
#undef DMA_TILE
#undef BARM
#undef BARL
#undef TR8
#undef PKF
#undef MF4
#undef WAITL
#undef MSEG
#undef LSEG
  if (hi == 0) li_l[r32] = l_reg; asm volatile("s_waitcnt lgkmcnt(0)" ::: "memory");
  float rli[16];
#pragma unroll
  for (int r = 0; r < 16; ++r) rli[r] = __builtin_amdgcn_rcpf(li_l[crow(r, hi)]);
  __syncthreads();
  float* X = (float*)lds + wq * (32 * 128);
  if (cmap == 1) {
#pragma unroll
    for (int r = 0; r < 16; ++r)
#pragma unroll
      for (int d0 = 0; d0 < 4; ++d0) X[crow(r, hi) * 128 + d0 * 32 + r32] = o[d0][r] * (rli[r] * lam);
  }
  __syncthreads();
  if (cmap == 0) {
    float gv[4];
#pragma unroll
    for (int d0 = 0; d0 < 4; ++d0) gv[d0] = subg[d0 * 32 + r32] * outscale;
#pragma unroll
    for (int r = 0; r < 16; ++r) { float ss = 0.f;
#pragma unroll
      for (int d0 = 0; d0 < 4; ++d0) { const float v = o[d0][r] * rli[r] - X[crow(r, hi) * 128 + d0 * 32 + r32]; o[d0][r] = v; ss += v * v; }
      ss = half_sum(ss);
      const float rstd = 1.0f / sqrtf(ss * (1.f / 128.f) + 1e-6f);
#pragma unroll
      for (int d0 = 0; d0 < 4; ++d0) o[d0][r] *= rstd * gv[d0]; }
    asm volatile("s_waitcnt lgkmcnt(0)" ::: "memory");
    bf16* stg = (bf16*)X;
#pragma unroll
    for (int r = 0; r < 16; ++r)
#pragma unroll
      for (int d0 = 0; d0 < 4; ++d0) stg[crow(r, hi) * 128 + d0 * 32 + r32] = (bf16)(pg8::cvt_pk_op(o[d0][r], 0.f) & 0xffffu);
    asm volatile("s_waitcnt lgkmcnt(0)" ::: "memory");
    bf16* Yw = Y + (size_t)(base + q0 + wq * 32) * 2048 + 1024 + h * 128;
#pragma unroll
    for (int i = 0; i < 8; ++i) { const int row = i * 4 + (lane >> 4), ch = lane & 15; const u32x4 v = *(const u32x4*)(stg + row * 128 + ch * 8); *(u32x4*)(Yw + (size_t)row * 2048 + ch * 8) = v; }
  }
  __syncthreads();
#undef QKT
#undef QKTF
#undef PSM
#undef RESC
}

struct AStage { bf16x8 vs0, vs1, ks0, ks1; };
struct ANext { bool has; const bf16* Kh; const bf16* Vh; const bf16* Qh; size_t rstride; int a, L; };
__device__ __forceinline__ void attn_a_unit(const bf16* __restrict__ QKV, bf16* __restrict__ OA, float* __restrict__ LSE, int base, int L, int dil, int rho, int a, int h, char* lds, AStage& st0, AStage& st1, bf16x8 (&qr)[8], bool pre, const ANext nx) {
  int tid_ = threadIdx.x; asm volatile("" : "+v"(tid_));
  const int tid = tid_, wid = __builtin_amdgcn_readfirstlane(tid >> 6), lane = tid & 63, r32 = lane & 31, hi = lane >> 5;
  char* V_lds = lds; char* K_lds = lds + 2 * SHM_V;
  float* ws = (float*)(lds + LDS_WSF) + wid * 64; float* li_l = ws; float* al_l = ws + 32;
  float m_reg = -1e30f, l_reg = 0; f32x16 o[4] = {};
  const int qs = a + wid * 32 + r32;
  const bf16* Qw = secp(QKV, 0, h) + (size_t)(base + rho + dil * qs) * HD + hi * 8;
#pragma unroll
  for (int d0 = 0; d0 < 8; ++d0) if (!pre) qr[d0] = *reinterpret_cast<const bf16x8*>(Qw + d0 * 16);
  const bf16* Kh = secp(QKV, 1, h) + (size_t)(base + rho) * HD; const bf16* Vh = secp(QKV, 2, h) + (size_t)(base + rho) * HD;
  const int sr = tid >> 4, sc = (tid & 15) * 8, vst0 = v_st(sr, sc), vst1 = v_st(32 + sr, sc);
  const int vb0 = (int)(uintptr_t)V_lds + v_rd_base(lane);
  constexpr float C = 0.08838834764831845f * LOG2E;
  const float nslope = -LOG2E * (float)dil * __builtin_amdgcn_exp2f(-0.5f * (float)(2 * h + 1));
  const size_t rstride = (size_t)dil * HD;
#define SLOADX(st, t, Kh_, Vh_, rs_, a_, L_) do { int k0_ = (a_) - 64 + 64 * (t) + sr, k1_ = k0_ + 32; k0_ = k0_ < 0 ? 0 : (k0_ >= (L_) ? (L_) - 1 : k0_); k1_ = k1_ < 0 ? 0 : (k1_ >= (L_) ? (L_) - 1 : k1_); \
    st.vs0 = *(const bf16x8*)(&(Vh_)[(size_t)k0_ * (rs_) + sc]); st.vs1 = *(const bf16x8*)(&(Vh_)[(size_t)k1_ * (rs_) + sc]); \
    st.ks0 = *(const bf16x8*)(&(Kh_)[(size_t)k0_ * (rs_) + sc]); st.ks1 = *(const bf16x8*)(&(Kh_)[(size_t)k1_ * (rs_) + sc]); } while (0)
#define SLOADA(st, t) SLOADX(st, t, Kh, Vh, rstride, a, L)
#define SWRITEA(st, b) do { *(bf16x8*)(V_lds + (b) * SHM_V + vst0) = st.vs0; *(bf16x8*)(V_lds + (b) * SHM_V + vst1) = st.vs1; const int kc_ = sc * 2; \
    *(bf16x8*)(K_lds + (b) * SHM_K + KSWZ(sr, kc_)) = st.ks0; *(bf16x8*)(K_lds + (b) * SHM_K + KSWZ(32 + sr, kc_)) = st.ks1; } while (0)
  if (!pre) { SLOADA(st0, 0); SLOADA(st1, 1); asm volatile("s_waitcnt vmcnt(4)" ::: "memory"); }
  SWRITEA(st0, 0); __syncthreads();
  const int t_lo = wid >> 1;
#define A_COMPUTE(t, b) do { \
    if ((t) >= t_lo && (t) <= t_lo + 2) { \
      f32x16 p0, p1; \
      qkt<8>(p0, p1, K_lds + (b) * SHM_K, qr, 0, r32, hi); \
      const int kb = a - 64 + 64 * (t) + 4 * hi; \
      const float dlt = (float)(qs - kb); \
      _Pragma("unroll") \
      for (int r = 0; r < 16; ++r) { const int kci = (r & 3) + 8 * (r >> 2); const float kc = (float)kci; \
        const float u0 = fabsf(dlt - kc), u1 = fabsf(dlt - (kc + 32.f)); \
        const bool ok0 = (u0 <= 64.f) && ((unsigned)(kb + kci) < (unsigned)L), ok1 = (u1 <= 64.f) && ((unsigned)(kb + kci + 32) < (unsigned)L); \
        p0[r] = ok0 ? fmaf(p0[r], C, u0 * nslope) : -INFINITY; p1[r] = ok1 ? fmaf(p1[r], C, u1 * nslope) : -INFINITY; } \
      float pmax = p0[0]; \
      _Pragma("unroll") \
      for (int r = 1; r < 16; ++r) pmax = fmaxf(pmax, p0[r]); \
      _Pragma("unroll") \
      for (int r = 0; r < 16; ++r) pmax = fmaxf(pmax, p1[r]); \
      { auto rr = __builtin_amdgcn_permlane32_swap(__float_as_uint(pmax), __float_as_uint(pmax), false, false); pmax = fmaxf(__uint_as_float(rr[0]), __uint_as_float(rr[1])); } \
      const float mn = fmaxf(m_reg, pmax), alpha = __builtin_amdgcn_exp2f(m_reg - mn); m_reg = mn; \
      _Pragma("unroll") \
      for (int r = 0; r < 16; ++r) { p0[r] = __builtin_amdgcn_exp2f(p0[r] - mn); p1[r] -= mn; } \
      bf16x8 pa0, pa1, pa2, pa3; \
      finishSM(p0, p1, alpha, l_reg, pa0, pa1, pa2, pa3); \
      if (__any(alpha < 1.f)) { if (hi == 0) al_l[r32] = alpha; asm volatile("s_waitcnt lgkmcnt(0)" ::: "memory"); \
      _Pragma("unroll") \
        for (int d = 0; d < 4; ++d) \
      _Pragma("unroll") \
          for (int r = 0; r < 16; ++r) o[d][r] *= al_l[crow(r, hi)]; } \
      SBAR(); \
      pv_d0(o, vb0 + (b) * SHM_V, pa0, pa1, pa2, pa3); \
    } \
  } while (0)
#pragma unroll 1
  for (int t = 0; t < 6; t += 2) {
    if (t + 2 < 6) SLOADA(st0, t + 2); else if (nx.has) SLOADX(st0, 0, nx.Kh, nx.Vh, nx.rstride, nx.a, nx.L);
    A_COMPUTE(t, 0);
    if (t + 2 < 6 || nx.has) asm volatile("s_waitcnt vmcnt(4)" ::: "memory"); else asm volatile("s_waitcnt vmcnt(0)" ::: "memory");
    SWRITEA(st1, 1);
    __syncthreads();
    if (t + 3 < 6) SLOADA(st1, t + 3); else if (nx.has) SLOADX(st1, 1, nx.Kh, nx.Vh, nx.rstride, nx.a, nx.L);
    A_COMPUTE(t + 1, 1);
    if (t + 2 < 6) { if (t + 3 < 6) asm volatile("s_waitcnt vmcnt(4)" ::: "memory"); else asm volatile("s_waitcnt vmcnt(0)" ::: "memory"); SWRITEA(st0, 0); }
    __syncthreads();
  }
#undef A_COMPUTE
  if (nx.has) { const bf16* Qn = nx.Qh + (size_t)(nx.a + wid * 32 + r32) * nx.rstride + hi * 8;
#pragma unroll
    for (int d0 = 0; d0 < 8; ++d0) qr[d0] = *reinterpret_cast<const bf16x8*>(Qn + d0 * 16); }
  if (hi == 0) li_l[r32] = l_reg; asm volatile("s_waitcnt lgkmcnt(0)" ::: "memory");
  float rli[16];
#pragma unroll
  for (int r = 0; r < 16; ++r) rli[r] = __builtin_amdgcn_rcpf(li_l[crow(r, hi)]);
  bf16* stg = (bf16*)lds + wid * (32 * 128);
#pragma unroll
  for (int r = 0; r < 16; ++r)
#pragma unroll
    for (int d0 = 0; d0 < 4; ++d0) stg[crow(r, hi) * 128 + d0 * 32 + r32] = (bf16)(cvtpk(o[d0][r] * rli[r], 0.f) & 0xffffu);
  asm volatile("s_waitcnt lgkmcnt(0)" ::: "memory");
  const size_t tok0 = (size_t)base + rho + (size_t)dil * (a + wid * 32);
#pragma unroll
  for (int i = 0; i < 8; ++i) { const int row = i * 4 + (lane >> 4), ch = lane & 15; const u32x4 v = *(const u32x4*)(stg + row * 128 + ch * 8);
    *(u32x4*)(OA + (tok0 + (size_t)dil * row) * 1024 + h * 128 + ch * 8) = v; }
  if (hi == 0) LSE[(tok0 + (size_t)dil * r32) * 8 + h] = m_reg + __builtin_amdgcn_logf(l_reg);
  __syncthreads();
#undef SLOADA
#undef SLOADX
#undef SWRITEA
}
struct MergeLoads { float l0, l1, l2; u32x4 v[3][2]; };
__device__ __forceinline__ void attn_a_merge_load(MergeLoads& M, const bf16* __restrict__ OA, const float* __restrict__ LSE, int tok, int lane) {
  const int h = lane >> 3, dseg = (lane & 7) * 16;
  M.l0 = LSE[(size_t)tok * 8 + h]; M.l1 = LSE[((size_t)NTOK + tok) * 8 + h]; M.l2 = LSE[((size_t)2 * NTOK + tok) * 8 + h];
#pragma unroll
  for (int b = 0; b < 3; ++b) { const u32x4* p = (const u32x4*)(OA + ((size_t)b * NTOK + tok) * 1024 + h * 128 + dseg); M.v[b][0] = p[0]; M.v[b][1] = p[1]; }
}
__device__ __forceinline__ void attn_a_merge_finish(const MergeLoads& M, bf16* __restrict__ Y, const f32x4 (&gq)[4], int tok, int lane) {
  const int h = lane >> 3, dseg = (lane & 7) * 16;
  float w[3]; { const float mx = fmaxf(M.l0, fmaxf(M.l1, M.l2)); w[0] = __builtin_amdgcn_exp2f(M.l0 - mx); w[1] = __builtin_amdgcn_exp2f(M.l1 - mx); w[2] = __builtin_amdgcn_exp2f(M.l2 - mx);
    const float rs = 1.f / (w[0] + w[1] + w[2]); w[0] *= rs; w[1] *= rs; w[2] *= rs; }
  float acc[16];
#pragma unroll
  for (int e = 0; e < 16; ++e) acc[e] = 0.f;
#pragma unroll
  for (int b = 0; b < 3; ++b) { const u32x4 v0 = M.v[b][0], v1 = M.v[b][1];
#pragma unroll
    for (int e = 0; e < 4; ++e) { acc[2 * e] += w[b] * __uint_as_float(v0[e] << 16); acc[2 * e + 1] += w[b] * __uint_as_float(v0[e] & 0xffff0000u);
                                  acc[8 + 2 * e] += w[b] * __uint_as_float(v1[e] << 16); acc[8 + 2 * e + 1] += w[b] * __uint_as_float(v1[e] & 0xffff0000u); } }
  float ss = 0.f;
#pragma unroll
  for (int e = 0; e < 16; ++e) ss += acc[e] * acc[e];
  ss += __shfl_xor(ss, 1); ss += __shfl_xor(ss, 2); ss += __shfl_xor(ss, 4);
  const float rstd = 1.0f / sqrtf(ss * (1.f / 128.f) + 1e-6f);
  u32x4 o0, o1;
#pragma unroll
  for (int e = 0; e < 4; ++e) { o0[e] = pg8::cvt_pk_op(acc[2 * e] * rstd * gq[(2 * e) >> 2][(2 * e) & 3], acc[2 * e + 1] * rstd * gq[(2 * e + 1) >> 2][(2 * e + 1) & 3]);
                                o1[e] = pg8::cvt_pk_op(acc[8 + 2 * e] * rstd * gq[(8 + 2 * e) >> 2][(8 + 2 * e) & 3], acc[8 + 2 * e + 1] * rstd * gq[(9 + 2 * e) >> 2][(9 + 2 * e) & 3]); }
  u32x4* yo = (u32x4*)(Y + (size_t)tok * 2048 + h * 128 + dseg); yo[0] = o0; yo[1] = o1;
}
__device__ __forceinline__ void attn_a_merge_row(const bf16* __restrict__ OA, const float* __restrict__ LSE, bf16* __restrict__ Y, const float* __restrict__ g, int tok, int lane) {
  f32x4 gq[4]; for (int k = 0; k < 4; ++k) gq[k] = *(const f32x4*)(g + (lane & 7) * 16 + 4 * k);
  MergeLoads M; attn_a_merge_load(M, OA, LSE, tok, lane); attn_a_merge_finish(M, Y, gq, tok, lane);
}
#undef KSWZ
#undef SBAR
}
__device__ __forceinline__ void p0_item(const float* W, int K, int N, bf16* WT, int mode, const float* g, const float* b, pg8::vec_t* cs, pg8::vec_t* bw, LAS unsigned* stg, int item, int lane) {
    const int nblk = N / 64, kgi = item / nblk, nb = item % nblk, n0 = 64 * nb;
    const int r0 = mode == 0 ? n0 : ((n0 >> 7) * 256 + (n0 & 127) + (mode == 2 ? 128 : 0));
    const int kq = lane & 3, nq = lane >> 2;
    f32x4 acs = {0.f, 0.f, 0.f, 0.f}, abw = {0.f, 0.f, 0.f, 0.f};
    for (int kb = kgi * 4; kb < kgi * 4 + 4; ++kb) {
        const int k0 = 64 * kb + 16 * kq;
        const GAS float* wp = (const GAS float*)W + (size_t)k0 * N + n0 + 4 * nq;
        f32x4 v[16];
#pragma unroll
        for (int j = 0; j < 16; ++j) v[j] = *(const GAS f32x4*)(wp + (size_t)j * N);
        unsigned pk[4][8];
        if (g) {
            f32x4 gq[4], bq[4];
#pragma unroll
            for (int t = 0; t < 4; ++t) { gq[t] = *(const GAS f32x4*)(g + k0 + 4 * t); bq[t] = *(const GAS f32x4*)(b + k0 + 4 * t); }
#pragma unroll
            for (int p = 0; p < 8; ++p) { const float g0 = gq[(2 * p) >> 2][(2 * p) & 3], g1 = gq[(2 * p + 1) >> 2][(2 * p + 1) & 3], b0 = bq[(2 * p) >> 2][(2 * p) & 3], b1 = bq[(2 * p + 1) >> 2][(2 * p + 1) & 3];
#pragma unroll
                for (int e = 0; e < 4; ++e) { const float w0 = v[2 * p][e], w1 = v[2 * p + 1][e]; const unsigned q = pg8::cvt_pk_op(w0 * g0, w1 * g1); pk[e][p] = q;
                    acs[e] += pg8::op_lo(q) + pg8::op_hi(q); abw[e] = fmaf(b0, w0, fmaf(b1, w1, abw[e])); } }
        } else {
#pragma unroll
            for (int p = 0; p < 8; ++p)
#pragma unroll
                for (int e = 0; e < 4; ++e) pk[e][p] = pg8::cvt_pk_op(v[2 * p][e], v[2 * p + 1][e]);
        }
#pragma unroll
        for (int e = 0; e < 4; ++e) { LAS v4u* rowp = (LAS v4u*)(stg + (4 * nq + e) * 36 + 8 * kq);
            rowp[0] = (v4u){pk[e][0], pk[e][1], pk[e][2], pk[e][3]}; rowp[1] = (v4u){pk[e][4], pk[e][5], pk[e][6], pk[e][7]}; }
        LDS_WAIT(); asm volatile("" ::: "memory");
#pragma unroll
        for (int i = 0; i < 8; ++i) { const int row = i * 8 + (lane >> 3), c = lane & 7; const v4u o = *(const LAS v4u*)(stg + row * 36 + 4 * c);
            *(GAS v4u*)(WT + (size_t)(r0 + row) * K + 64 * kb + 8 * c) = o; }
        LDS_WAIT(); asm volatile("" ::: "memory");
    }
    if (g) {
#pragma unroll
        for (int e = 0; e < 4; ++e) { acs[e] += __shfl_xor(acs[e], 1); acs[e] += __shfl_xor(acs[e], 2); abw[e] += __shfl_xor(abw[e], 1); abw[e] += __shfl_xor(abw[e], 2); }
        if (kq == 0) {
#pragma unroll
            for (int e = 0; e < 4; ++e) { __hip_atomic_fetch_add(cs + r0 + 4 * nq + e, (int)__builtin_rintf(acs[e] * pg8::VEC_SCALE), __ATOMIC_RELAXED, __HIP_MEMORY_SCOPE_AGENT); __hip_atomic_fetch_add(bw + r0 + 4 * nq + e, (int)__builtin_rintf(abw[e] * pg8::VEC_SCALE), __ATOMIC_RELAXED, __HIP_MEMORY_SCOPE_AGENT); } }
    }
}
struct Args { const float* in[NIN]; float* out; unsigned char* ws; int ph_lo, ph_hi; };

constexpr int CV_I_GU = (DFF / 64) * (DM / 256), CV_I_D = (DM / 64) * (DFF / 256), CV_I_IN = (INW / 64) * (DM / 256), CV_I_OUT = (DM / 64) * (DM / 256);
constexpr int CV_I_LAYER = 4 * CV_I_GU + 2 * CV_I_D + CV_I_IN + CV_I_OUT;
#ifndef MK_CV_TAIL_LO
#define MK_CV_TAIL_LO 0
#endif
constexpr int CV_TAIL_LO = MK_CV_TAIL_LO;
__device__ __forceinline__ void convert_layer_items(Frame& F, const Args& a, int l, int lo, int hi, int widx, int nw) {
    LAS unsigned* scr = (LAS unsigned*)(F.lds + RING_OFF + F.wave * 16384);
    unsigned char* wl = a.ws + WS_W + (size_t)l * SZ_LAYER;
    pg8::vec_t* vec = (pg8::vec_t*)(a.ws + WS_VEC) + (size_t)l * V_LAYER;
    const float* g1 = l ? a.in[20] + (l - 1) * DM : nullptr; const float* b1 = l ? a.in[21] + (l - 1) * DM : nullptr;
    for (int it = lo + widx; it < hi; it += nw) {
        int r = it;
        if (r < CV_I_GU) { p0_item(a.in[4] + (size_t)l * DM * DFF, DM, DFF, (bf16*)(wl + OFF_W1A), 1, g1, b1, vec + V_CS1, vec + V_BW1, scr, r, flane()); continue; } r -= CV_I_GU;
        if (r < CV_I_GU) { p0_item(a.in[5] + (size_t)l * DM * DFF, DM, DFF, (bf16*)(wl + OFF_W1A), 2, g1, b1, vec + V_CS1, vec + V_BW1, scr, r, flane()); continue; } r -= CV_I_GU;
        if (r < CV_I_D)  { p0_item(a.in[6] + (size_t)l * DFF * DM, DFF, DM, (bf16*)(wl + OFF_WD1), 0, nullptr, nullptr, nullptr, nullptr, scr, r, flane()); continue; } r -= CV_I_D;
        if (r < CV_I_IN) { p0_item(a.in[7] + (size_t)l * DM * INW, DM, INW, (bf16*)(wl + OFF_WIN), 0, a.in[2] + l * DM, a.in[3] + l * DM, vec + V_CSIN, vec + V_BWIN, scr, r, flane()); continue; } r -= CV_I_IN;
        if (r < CV_I_OUT){ p0_item(a.in[14] + (size_t)l * DM * DM, DM, DM, (bf16*)(wl + OFF_WOUT), 0, nullptr, nullptr, nullptr, nullptr, scr, r, flane()); continue; } r -= CV_I_OUT;
        if (r < CV_I_GU) { p0_item(a.in[17] + (size_t)l * DM * DFF, DM, DFF, (bf16*)(wl + OFF_W2A), 1, a.in[15] + l * DM, a.in[16] + l * DM, vec + V_CS2, vec + V_BW2, scr, r, flane()); continue; } r -= CV_I_GU;
        if (r < CV_I_GU) { p0_item(a.in[18] + (size_t)l * DM * DFF, DM, DFF, (bf16*)(wl + OFF_W2A), 2, a.in[15] + l * DM, a.in[16] + l * DM, vec + V_CS2, vec + V_BW2, scr, r, flane()); continue; } r -= CV_I_GU;
        p0_item(a.in[19] + (size_t)l * DFF * DM, DFF, DM, (bf16*)(wl + OFF_WD2), 0, nullptr, nullptr, nullptr, nullptr, scr, r, flane());
    }
}
__device__ __forceinline__ void p0_prologue(Frame& F, const Args& a) {
    const int gw = F.vcu * NWAVES + F.wave, NGW = F.G * NWAVES;
    for (int l = 0; l < DEPTH; ++l) convert_layer_items(F, a, l, 0, (l == 0 || F.G != 256) ? CV_I_LAYER : CV_TAIL_LO, gw, NGW);
    bf16* XN = (bf16*)(a.ws + WS_XN); unsigned char* YL = a.ws + WS_YL;
    pg8::st_t* ST = (pg8::st_t*)(a.ws + WS_ST);
    f32x4 xn[8];
    if (gw < NTOK) { const float* src = gw < S_PROMPT ? a.in[0] + (size_t)gw * DM : a.in[1] + (size_t)(gw - S_PROMPT) * DM; const GAS f32x4* xr = (const GAS f32x4*)src + flane();
#pragma unroll
        for (int j = 0; j < 8; ++j) xn[j] = xr[64 * j]; }
    for (int m = gw; m < NTOK; m += NGW) {
        f32x4 xc[8];
#pragma unroll
        for (int j = 0; j < 8; ++j) xc[j] = xn[j];
        if (m + NGW < NTOK) { const int mn = m + NGW; const float* src = mn < S_PROMPT ? a.in[0] + (size_t)mn * DM : a.in[1] + (size_t)(mn - S_PROMPT) * DM; const GAS f32x4* xr = (const GAS f32x4*)src + flane();
#pragma unroll
            for (int j = 0; j < 8; ++j) xn[j] = xr[64 * j]; }
        GAS unsigned long long* o8 = (GAS unsigned long long*)(XN + (size_t)m * DM) + flane();
#pragma unroll
        for (int j = 0; j < 8; ++j) { const f32x4 v = xc[j]; const unsigned h0 = pg8::cvt_pk_op(v.x, v.y), h1 = pg8::cvt_pk_op(v.z, v.w);
            o8[64 * j] = (unsigned long long)h0 | ((unsigned long long)h1 << 32); }
        if (flane() == 0) { ST[2 * m] = 0; ST[2 * m + 1] = pg8::st_fix((float)DM * (1.0f - LN_EPS)); ST[2 * (NTOK + m)] = 0; ST[2 * (NTOK + m) + 1] = 0; }
    }
    if (gw == 0) { float* id = (float*)(a.ws + WS_ID); for (int e = flane(); e < DM; e += 64) { id[e] = 1.f; id[DM + e] = 0.f; } }
}
__device__ __forceinline__ void ln_phase(Frame& F, const bf16* YH, const unsigned char* YL, float* OUT, const float* g, const float* b) {
    int lane_ = flane(); asm volatile("" : "+v"(lane_));
    const int gw = F.vcu * NWAVES + F.wave, NGW = F.G * NWAVES;
    f32x4 gv[8], bv[8];
#pragma unroll
    for (int j = 0; j < 4; ++j) { const int c = 512 * j + 8 * lane_; gv[2 * j] = *(const GAS f32x4*)(g + c); gv[2 * j + 1] = *(const GAS f32x4*)(g + c + 4); bv[2 * j] = *(const GAS f32x4*)(b + c); bv[2 * j + 1] = *(const GAS f32x4*)(b + c + 4); }
    v4u hn[4];
    if (gw < NTOK) { const GAS v4u* hr = (const GAS v4u*)(YH + (size_t)gw * DM) + lane_;
#pragma unroll
        for (int j = 0; j < 4; ++j) hn[j] = hr[64 * j]; }
    for (int m = gw; m < NTOK; m += NGW) {
        f32x4 v[8]; float s = 0.f;
#pragma unroll
        for (int j = 0; j < 4; ++j) { const v4u h = hn[j];
            v[2 * j] = (f32x4){pg8::op_lo(h.x), pg8::op_hi(h.x), pg8::op_lo(h.y), pg8::op_hi(h.y)};
            v[2 * j + 1] = (f32x4){pg8::op_lo(h.z), pg8::op_hi(h.z), pg8::op_lo(h.w), pg8::op_hi(h.w)};
            s += ((v[2 * j].x + v[2 * j].y) + (v[2 * j].z + v[2 * j].w)) + ((v[2 * j + 1].x + v[2 * j + 1].y) + (v[2 * j + 1].z + v[2 * j + 1].w)); }
        if (m + NGW < NTOK) { const GAS v4u* hr = (const GAS v4u*)(YH + (size_t)(m + NGW) * DM) + lane_;
#pragma unroll
            for (int j = 0; j < 4; ++j) hn[j] = hr[64 * j]; }
        const float mean = wave_sum(s) * (1.f / DM); float s2 = 0.f;
#pragma unroll
        for (int j = 0; j < 8; ++j) { v[j] = v[j] - mean; s2 += (v[j].x * v[j].x + v[j].y * v[j].y) + (v[j].z * v[j].z + v[j].w * v[j].w); }
        const float rstd = 1.f / sqrtf(wave_sum(s2) * (1.f / DM) + LN_EPS);
#pragma unroll
        for (int j = 0; j < 4; ++j) { const int c = 512 * j + 8 * lane_;
            *(GAS f32x4*)(OUT + (size_t)m * DM + c) = v[2 * j] * rstd * gv[2 * j] + bv[2 * j]; *(GAS f32x4*)(OUT + (size_t)m * DM + c + 4) = v[2 * j + 1] * rstd * gv[2 * j + 1] + bv[2 * j + 1]; }
    }
}

struct AUnit { int h, br, base, L, dil, rho, a; };
__device__ __forceinline__ AUnit a_unit_of(int uid) {
    AUnit u; u.h = (uid >> 5) & 7; const int rem = (uid >> 8) * 32 + (uid & 31), blk = rem % 96; u.br = rem / 96; u.dil = 1 << (2 * u.br);
    int S, j; if (blk < 32) { u.base = 0; S = S_PROMPT; j = blk; } else { u.base = S_PROMPT + S_SAMPLE * ((blk - 32) >> 4); S = S_SAMPLE; j = (blk - 32) & 15; }
    u.rho = j % u.dil; u.a = (j / u.dil) * 256; u.L = S / u.dil; return u;
}
__device__ __forceinline__ void attn_a_phase(Frame& F, const bf16* QKV, bf16* OA, float* LSE, char* lds) {
    att::AStage st0, st1; bf16x8 qr[8];
    for (int it = 0;; ++it) {
        const int uid = it * F.G + F.vcu; if (uid >= 2304) break;
        const AUnit u = a_unit_of(uid);
        const int nuid = uid + F.G; att::ANext nx; nx.has = nuid < 2304;
        { const AUnit v = a_unit_of(nx.has ? nuid : uid); nx.Kh = att::secp(QKV, 1, v.h) + (size_t)(v.base + v.rho) * att::HD; nx.Qh = att::secp(QKV, 0, v.h) + (size_t)(v.base + v.rho) * att::HD; nx.Vh = att::secp(QKV, 2, v.h) + (size_t)(v.base + v.rho) * att::HD;
          nx.rstride = (size_t)v.dil * att::HD; nx.a = v.a; nx.L = v.L; }
        att::attn_a_unit(QKV, OA + (size_t)u.br * NTOK * 1024, LSE + (size_t)u.br * NTOK * 8, u.base, u.L, u.dil, u.rho, u.a, u.h, lds, st0, st1, qr, it > 0, nx);
    }
}
__device__ __forceinline__ void attn_a_merge_phase(Frame& F, const bf16* OA, const float* LSE, bf16* Y, const float* g) {
    const int gw = F.vcu * NWAVES + F.wave, NGW = F.G * NWAVES;
    int lane_ = flane(); asm volatile("" : "+v"(lane_));
    for (int m = gw; m < NTOK; m += NGW) att::attn_a_merge_row(OA, LSE, Y, g, m, lane_);
}
__device__ __forceinline__ void kn_phase(Frame& F, const bf16* QKV, gu32* KN) {
    int lane_ = flane(); asm volatile("" : "+v"(lane_));
    LAS unsigned* kl = (LAS unsigned*)(F.lds + KNL_OFF);
    const int gw = F.vcu * NWAVES + F.wave, NGW = F.G * NWAVES;
    for (int m0 = gw; m0 < NTOK; m0 += 6 * NGW) {
        v4u v0[6], v1[6];
#pragma unroll
        for (int k = 0; k < 6; ++k) { const int m = m0 + k * NGW; if (m < NTOK) {
            const GAS v4u* p = (const GAS v4u*)(QKV + ((size_t)(4 * 8 + (lane_ >> 3)) * NTOK + m) * 128 + (lane_ & 7) * 16); v0[k] = p[0]; v1[k] = p[1]; } }
#pragma unroll
        for (int k = 0; k < 6; ++k) { const int m = m0 + k * NGW; if (m < NTOK) {
            float ss = 0.f;
#pragma unroll
            for (int e = 0; e < 4; ++e) { const float a = __uint_as_float(v0[k][e] << 16), b = __uint_as_float(v0[k][e] & 0xffff0000u), c = __uint_as_float(v1[k][e] << 16), d = __uint_as_float(v1[k][e] & 0xffff0000u);
                ss += (a * a + b * b) + (c * c + d * d); }
            ss += __shfl_xor(ss, 1); ss += __shfl_xor(ss, 2);
            const int seq = m < S_PROMPT ? 0 : 1 + ((m - S_PROMPT) >> 12);
            if ((lane_ & 3) == 0) __hip_atomic_fetch_max(kl + seq * 16 + (lane_ >> 2), __float_as_uint(ss), __ATOMIC_RELAXED, __HIP_MEMORY_SCOPE_WORKGROUP); } }
    }
    LDS_WAIT(); __syncthreads();
    int tid_ = ftid(); asm volatile("" : "+v"(tid_));
    if (tid_ < 80) { const unsigned v = kl[tid_]; kl[tid_] = 0u; if (v) __hip_atomic_fetch_max(KN + tid_, v, RLX_AGENT); }
    __syncthreads();
}
__device__ __forceinline__ void attn_b_phase(Frame& F, const bf16* QKV, bf16* Y, const float* q1, const float* k1, const float* q2, const float* k2, const float* subg, int layer, gu32* QH, const float* KN, const bf16* OA, const float* LSE, const float* ga, char* lds) {
    int lane_ = flane(); asm volatile("" : "+v"(lane_));
    const float s1 = wave_sum(q1[lane_] * k1[lane_]), s2 = wave_sum(q2[lane_] * k2[lane_]);
    const float lam_init = 0.8f - 0.6f * expf(-0.3f * (float)layer), lam = __uint_as_float(__builtin_amdgcn_readfirstlane(__float_as_uint(expf(s1) - expf(s2) + lam_init)));
    const unsigned xcd = xb_xcc_id() & 7u;
    for (int s = 0; s < 8; ++s) {
        const int q = (int)((xcd + (unsigned)s) & 7u), lo = B_CHUNK[q], hiU = B_CHUNK[q + 1];
        for (;;) {
            if (ftid() == 256) F.MISC[16] = __hip_atomic_fetch_add(QH + 64 * q, 1u, RLX_AGENT);
            __syncthreads();
            const int idx = lo + (int)F.MISC[16];
            __syncthreads();
            if (idx >= hiU) break;
            const unsigned u = B_UNITS[idx];
            if (u >= 0x7000u) {
                const int c0 = (int)(u & 0xfffu) * 96;
                const int ml_ = flane();
                f32x4 gq_[4];
#pragma unroll
                for (int k = 0; k < 4; ++k) gq_[k] = *(const GAS f32x4*)(ga + (ml_ & 7) * 16 + 4 * k);
                for (int m = c0 + F.wave; m < c0 + 96; m += 4 * NWAVES) {
                    att::MergeLoads M0, M1, M2, M3;
                    att::attn_a_merge_load(M0, OA, LSE, m, ml_); att::attn_a_merge_load(M1, OA, LSE, m + NWAVES, ml_); att::attn_a_merge_load(M2, OA, LSE, m + 2 * NWAVES, ml_); att::attn_a_merge_load(M3, OA, LSE, m + 3 * NWAVES, ml_);
                    att::attn_a_merge_finish(M0, Y, gq_, m, ml_); att::attn_a_merge_finish(M1, Y, gq_, m + NWAVES, ml_); att::attn_a_merge_finish(M2, Y, gq_, m + 2 * NWAVES, ml_); att::attn_a_merge_finish(M3, Y, gq_, m + 3 * NWAVES, ml_);
                }
                continue;
            }
            const int seq = (int)(u >> 12), h = (int)((u >> 8) & 7u), qb = (int)(u & 255u);
            const int base = seq == 0 ? 0 : S_PROMPT + S_SAMPLE * (seq - 1), S = seq == 0 ? S_PROMPT : S_SAMPLE;
            att::attn_b_unit(QKV, Y, base, S, h, qb * 128, lam, subg, 1.0f - lam_init, KN + seq * 16 + h * 2, lds);
        }
    }
}
__device__ __forceinline__ void up_tail_convert(Frame& F, const Args& a, int l_next, int part) {
    if (F.G != 256 || l_next >= DEPTH || MK_CIDX < 128) return;
    const int half = CV_TAIL_LO + (CV_I_LAYER - CV_TAIL_LO) / 2, lo = part ? half : CV_TAIL_LO, hi = part ? CV_I_LAYER : half;
    __syncthreads();
    convert_layer_items(F, a, l_next, lo, hi, (MK_CIDX - 128) * NWAVES + F.wave, 128 * NWAVES);
}
#if MK_STAG50
__device__ __forceinline__ void stag50(unsigned ticks) { if (blockIdx.x < 128) { const unsigned long long t0 = rt(); while (rt() - t0 < ticks) __builtin_amdgcn_s_sleep(8); } }
#endif
__global__ void __launch_bounds__(NWAVES * 64, 2) mk_fwd(Args args) {
    extern __shared__ __attribute__((aligned(16))) unsigned char lds[];
    Frame F;
    F.lds = (LAS unsigned char*)lds;
    F.MISC = (volatile LAS unsigned*)(F.lds + MISC_OFF);
    F.wave = __builtin_amdgcn_readfirstlane((int)threadIdx.x >> 6);
    F.G = gridDim.x; { const int bx = blockIdx.x; F.vcu = (F.G % 8 == 0) ? (bx % 8) * (F.G / 8) + bx / 8 : bx; }
    unsigned char* ws = args.ws;
    F.ctl = (gu32*)(ws + WS_CTL);
    for (int u = ftid(); u < (LDS_BYTES - LDSCTL_OFF) / 4; u += NWAVES * 64) ((LAS unsigned*)(F.lds + LDSCTL_OFF))[u] = 0u;
    __syncthreads();
    const int lo = args.ph_lo, hi = args.ph_hi;
    XcdBarrier bar; bar.bar = (unsigned*)(F.ctl + CW_BAR); bar.x = 0; bar.st = nullptr;
    if (hi - lo > 1) bar = xcd_barrier_post((unsigned*)(F.ctl + CW_BAR), F.MISC + 8);
#define IN(k) (lo <= (k) && (k) < hi)
#define SEAM(k) do { if (IN(k) && IN((k) + 1)) xcd_barrier(bar); } while (0)
    bf16* XN = (bf16*)(ws + WS_XN); bf16* YB = (bf16*)(ws + WS_Y); bf16* QKV = (bf16*)(ws + WS_QKV); bf16* HB = (bf16*)(ws + WS_QKV);
    float* X = args.out; unsigned char* YLB = ws + WS_YL;

    if (IN(0)) { p0_prologue(F, args); SEAM(0); }
    pg8::st_t* STB = (pg8::st_t*)(ws + WS_ST); const float* IDV = (const float*)(ws + WS_ID);
#define ZERO_ST(p) do { pg8::st_t* z_ = (p) + (size_t)blockIdx.x * (2 * NTOK / 256); if (F.G == 256) { if (ftid() < 2 * NTOK / 256) z_[ftid()] = 0; } else if (blockIdx.x == 0) { for (int e_ = ftid(); e_ < 2 * NTOK; e_ += NWAVES * 64) (p)[e_] = 0; } } while (0)
    for (int l = 0; l < DEPTH; ++l) {
        const int pb = 1 + PH_PER_LAYER * l;
        unsigned char* wl = ws + WS_W + (size_t)l * SZ_LAYER;
        const pg8::vec_t* vec = (const pg8::vec_t*)(ws + WS_VEC) + (size_t)l * V_LAYER;
        const int par0 = __builtin_amdgcn_readfirstlane((3 * l) & 1);
        pg8::st_t* ST0 = STB + (size_t)par0 * (2 * NTOK); pg8::st_t* ST1 = STB + (size_t)(par0 ^ 1) * (2 * NTOK);
        if (IN(pb + 0)) {
            ZERO_ST(ST1);
            pg8::Gemm g{XN, (const bf16*)(wl + OFF_W1A), NTOK, NFF2, DM}; pg8::StaticOrder S; S.init(NTOK, NFF2, F.G, MK_CIDX, MK_WGM_UP);
            pg8::EpiSwigluLN E{HB, DFF, ST0, vec + V_CS1, vec + V_BW1};
#if MK_DUP_UP == 1
            _Pragma("nounroll") for (int rep_ = 0; rep_ < 2; ++rep_) { asm volatile("" ::: "memory"); __syncthreads();
#endif
#if MK_DUP_UP == 2
            { pg8::EpiNull EN; pg8::gemm_phase<pg8::EpiNull, pg8::StaticOrder, true, true>(F.lds + RING_OFF, g, S, EN); __syncthreads(); }
#endif
            pg8::gemm_phase<pg8::EpiSwigluLN, pg8::StaticOrder, MK_ALIGN_UP, MK_SP2>(F.lds + RING_OFF, g, S, E);
#if MK_DUP_UP == 1
            }
#endif
            up_tail_convert(F, args, l + 1, 0);
            SEAM(pb + 0);
        }
        if (IN(pb + 1)) {
            pg8::Gemm g{HB, (const bf16*)(wl + OFF_WD1), NTOK, DM, DFF}; pg8::StaticOrder S; S.init(NTOK, DM, F.G, MK_CIDX, 4);

#if MK_STAG50
            stag50(MK_STAG50);
#endif
            pg8::EpiResidLN E{XN, YLB, XN, YLB, DM, ST0, ST1, l ? args.in[20] + (l - 1) * DM : IDV, l ? args.in[21] + (l - 1) * DM : IDV + DM, ALPHA, 0.5f};
#if MK_DUP_DOWN == 1
            _Pragma("nounroll") for (int rep_ = 0; rep_ < 2; ++rep_) { asm volatile("" ::: "memory"); __syncthreads();
            E.YHo = rep_ ? XN : (bf16*)(ws + WS_OA); E.YLo = rep_ ? YLB : ws + WS_OA + SZ_XN; E.STn = rep_ ? ST1 : (pg8::st_t*)(ws + WS_LSE);
#endif
#if MK_DUP_DOWN == 2
            { pg8::EpiNull EN; pg8::gemm_phase<pg8::EpiNull, pg8::StaticOrder, true, true>(F.lds + RING_OFF, g, S, EN); __syncthreads(); }
#endif
            pg8::gemm_phase<pg8::EpiResidLN, pg8::StaticOrder, MK_ALIGN_RESID, MK_SP2, MK_AUX_RESID>(F.lds + RING_OFF, g, S, E);
#if MK_DUP_DOWN == 1
            }
#endif
            SEAM(pb + 1);
        }
        if (IN(pb + 2)) {
            ZERO_ST(ST0);
            pg8::Gemm g{XN, (const bf16*)(wl + OFF_WIN), NTOK, INW, DM}; pg8::StaticOrder S; S.init(NTOK, INW, F.G, MK_CIDX, MK_WGM_UP);
            pg8::EpiBf16LN E{QKV, NTOK, ST1, vec + V_CSIN, vec + V_BWIN};
#if MK_DUP_WIN
            _Pragma("nounroll") for (int rep_ = 0; rep_ < 2; ++rep_) { asm volatile("" ::: "memory"); __syncthreads();
#endif
            pg8::gemm_phase<pg8::EpiBf16LN, pg8::StaticOrder, true, MK_SP2>(F.lds + RING_OFF, g, S, E);
#if MK_DUP_WIN
            }
#endif
            SEAM(pb + 2);
        }
        if (IN(pb + 3)) {
            kn_phase(F, QKV, F.ctl + CW_KN + l * 80);
            attn_a_phase(F, QKV, (bf16*)(ws + WS_OA), (float*)(ws + WS_LSE), (char*)lds + RING_OFF);
#if MK_DUP_A
            __syncthreads();
            attn_a_phase(F, QKV, (bf16*)(ws + WS_OA), (float*)(ws + WS_LSE), (char*)lds + RING_OFF);
#endif
            SEAM(pb + 3);
        }
        if (IN(pb + 4)) {
            attn_b_phase(F, QKV, YB, args.in[9] + l * 64, args.in[10] + l * 64, args.in[11] + l * 64, args.in[12] + l * 64, args.in[13] + l * 128, l, F.ctl + CW_QH + l * 512, (const float*)(ws + WS_CTL) + CW_KN + l * 80, (const bf16*)(ws + WS_OA), (const float*)(ws + WS_LSE), args.in[8] + l * 128, (char*)lds + RING_OFF);

            SEAM(pb + 4);
        }
        if (IN(pb + 5)) {
            pg8::Gemm g{YB, (const bf16*)(wl + OFF_WOUT), NTOK, DM, DM}; pg8::StaticOrder S; S.init(NTOK, DM, F.G, MK_CIDX, 4);
            pg8::EpiResidLN E{XN, YLB, XN, YLB, DM, ST1, ST0, args.in[2] + l * DM, args.in[3] + l * DM, ALPHA, 1.0f};
#if MK_DUP_WOUT
            _Pragma("nounroll") for (int rep_ = 0; rep_ < 2; ++rep_) { asm volatile("" ::: "memory"); __syncthreads();
            E.YHo = rep_ ? XN : (bf16*)(ws + WS_OA); E.YLo = rep_ ? YLB : ws + WS_OA + SZ_XN; E.STn = rep_ ? ST0 : (pg8::st_t*)(ws + WS_LSE);
#endif
            pg8::gemm_phase<pg8::EpiResidLN, pg8::StaticOrder, MK_ALIGN_RESID, MK_SP2, MK_AUX_RESID>(F.lds + RING_OFF, g, S, E);
#if MK_DUP_WOUT
            }
#endif
            SEAM(pb + 5);
        }
        if (IN(pb + 6)) {
            ZERO_ST(ST1);
            pg8::Gemm g{XN, (const bf16*)(wl + OFF_W2A), NTOK, NFF2, DM}; pg8::StaticOrder S; S.init(NTOK, NFF2, F.G, MK_CIDX, MK_WGM_UP);
            pg8::EpiSwigluLN E{HB, DFF, ST0, vec + V_CS2, vec + V_BW2};
            pg8::gemm_phase<pg8::EpiSwigluLN, pg8::StaticOrder, MK_ALIGN_UP, MK_SP2>(F.lds + RING_OFF, g, S, E);
            up_tail_convert(F, args, l + 1, 1);
            SEAM(pb + 6);
        }
        if (IN(pb + 7)) {
            pg8::Gemm g{HB, (const bf16*)(wl + OFF_WD2), NTOK, DM, DFF}; pg8::StaticOrder S; S.init(NTOK, DM, F.G, MK_CIDX, 4);

#if MK_STAG50
            stag50(MK_STAG50);
#endif
            pg8::EpiResidLN E{XN, YLB, XN, YLB, DM, ST0, ST1, args.in[15] + l * DM, args.in[16] + l * DM, ALPHA, 0.5f};
            pg8::gemm_phase<pg8::EpiResidLN, pg8::StaticOrder, MK_ALIGN_RESID, MK_SP2, MK_AUX_RESID>(F.lds + RING_OFF, g, S, E);
            SEAM(pb + 7);
        }
    }
    if (IN(N_PHASES - 1)) ln_phase(F, XN, YLB, X, args.in[20] + (DEPTH - 1) * DM, args.in[21] + (DEPTH - 1) * DM);
#undef IN
#undef SEAM
}

#if MK_G4TEST
__global__ void __launch_bounds__(256, 1) gemm4_fwd(Args args) {
    extern __shared__ __attribute__((aligned(16))) unsigned char lds4[];
    LAS unsigned char* L = (LAS unsigned char*)lds4;
    unsigned char* ws = args.ws; const int lo = args.ph_lo, hi = args.ph_hi, G = gridDim.x;
    const int wid4 = __builtin_amdgcn_readfirstlane((int)threadIdx.x >> 6);
    bf16* XN = (bf16*)(ws + WS_XN); bf16* YB = (bf16*)(ws + WS_Y); bf16* QKV = (bf16*)(ws + WS_QKV); bf16* HB = (bf16*)(ws + WS_QKV); unsigned char* YLB = ws + WS_YL;
    float* STB = (float*)(ws + WS_ST); const float* IDV = (const float*)(ws + WS_ID);
#define IN(k) (lo <= (k) && (k) < hi)
#define ZST(p) do { const int t_ = wid4 * 64 + pg8::lane_id4(); float* z_ = (p) + (size_t)blockIdx.x * (2 * NTOK / 256); if (t_ < 2 * NTOK / 256) z_[t_] = 0.f; } while (0)
    for (int l = 0; l < DEPTH; ++l) {
        const int pb = 1 + PH_PER_LAYER * l;
        unsigned char* wl = ws + WS_W + (size_t)l * SZ_LAYER;
        const float* vec = (const float*)(ws + WS_VEC) + (size_t)l * V_LAYER;
        float* ST0 = STB + (size_t)((3 * l) & 1) * (2 * NTOK); float* ST1 = STB + (size_t)((3 * l + 1) & 1) * (2 * NTOK);
        if (IN(pb + 0)) { ZST(ST1); pg8::Gemm g{XN, (const bf16*)(wl + OFF_W1A), NTOK, NFF2, DM}; pg8::StaticOrder S; S.init(NTOK, NFF2, G, MK_CIDX);
            pg8::EpiSwigluLN E{HB, DFF, ST0, vec + V_CS1, vec + V_BW1};
#if MK_G4TEST == 2
            { pg8::EpiNull EN; pg8::gemm_phase4<pg8::EpiNull, pg8::StaticOrder>(L, g, S, EN, wid4); }
#endif
            pg8::gemm_phase4<pg8::EpiSwigluLN, pg8::StaticOrder>(L, g, S, E, wid4); }
        if (IN(pb + 1)) { pg8::Gemm g{HB, (const bf16*)(wl + OFF_WD1), NTOK, DM, DFF}; pg8::StaticOrder S; S.init(NTOK, DM, G, MK_CIDX, 4);
            pg8::EpiResidLN E{XN, YLB, XN, YLB, DM, ST0, ST1, l ? args.in[20] + (l - 1) * DM : IDV, l ? args.in[21] + (l - 1) * DM : IDV + DM, ALPHA, 0.5f}; pg8::gemm_phase4<pg8::EpiResidLN, pg8::StaticOrder>(L, g, S, E, wid4); }
        if (IN(pb + 2)) { ZST(ST0); pg8::Gemm g{XN, (const bf16*)(wl + OFF_WIN), NTOK, INW, DM}; pg8::StaticOrder S; S.init(NTOK, INW, G, MK_CIDX);
            pg8::EpiBf16LN E{QKV, NTOK, ST1, vec + V_CSIN, vec + V_BWIN}; pg8::gemm_phase4<pg8::EpiBf16LN, pg8::StaticOrder>(L, g, S, E, wid4); }
        if (IN(pb + 5)) { pg8::Gemm g{YB, (const bf16*)(wl + OFF_WOUT), NTOK, DM, DM}; pg8::StaticOrder S; S.init(NTOK, DM, G, MK_CIDX, 4);
            pg8::EpiResidLN E{XN, YLB, XN, YLB, DM, ST1, ST0, args.in[2] + l * DM, args.in[3] + l * DM, ALPHA, 1.0f}; pg8::gemm_phase4<pg8::EpiResidLN, pg8::StaticOrder>(L, g, S, E, wid4); }
        if (IN(pb + 6)) { ZST(ST1); pg8::Gemm g{XN, (const bf16*)(wl + OFF_W2A), NTOK, NFF2, DM}; pg8::StaticOrder S; S.init(NTOK, NFF2, G, MK_CIDX);
            pg8::EpiSwigluLN E{HB, DFF, ST0, vec + V_CS2, vec + V_BW2}; pg8::gemm_phase4<pg8::EpiSwigluLN, pg8::StaticOrder>(L, g, S, E, wid4); }
        if (IN(pb + 7)) { pg8::Gemm g{HB, (const bf16*)(wl + OFF_WD2), NTOK, DM, DFF}; pg8::StaticOrder S; S.init(NTOK, DM, G, MK_CIDX, 4);
            pg8::EpiResidLN E{XN, YLB, XN, YLB, DM, ST0, ST1, args.in[15] + l * DM, args.in[16] + l * DM, ALPHA, 0.5f}; pg8::gemm_phase4<pg8::EpiResidLN, pg8::StaticOrder>(L, g, S, E, wid4); }
    }
#undef IN
#undef ZST
}
#endif

extern "C" void kernel_launch(void* const* d_in, const int* in_sizes, int n_in, void* d_out, int out_size, void* d_ws, size_t ws_size, hipStream_t stream) {
    static int grid = 0;
    if (grid == 0) {
        const size_t need = WS_END;
        if (n_in != NIN || out_size != NTOK * DM || ws_size < need) { fprintf(stderr, "kernel_launch: shape mismatch n_in %d out %d ws %zu (need %zu)\n", n_in, out_size, ws_size, need); grid = -1; return; }
        int dev = 0, cus = 0;
        if (hipGetDevice(&dev) != hipSuccess || hipDeviceGetAttribute(&cus, hipDeviceAttributeMultiprocessorCount, dev) != hipSuccess) { grid = -1; return; }
        if (hipFuncSetAttribute((const void*)mk_fwd, hipFuncAttributeMaxDynamicSharedMemorySize, LDS_BYTES) != hipSuccess) { fprintf(stderr, "kernel_launch: hipFuncSetAttribute failed\n"); grid = -1; return; }
        int per_cu = 0;
        if (hipOccupancyMaxActiveBlocksPerMultiprocessor(&per_cu, (const void*)mk_fwd, NWAVES * 64, LDS_BYTES) != hipSuccess || per_cu < 1) fprintf(stderr, "kernel_launch: occupancy query says %d\n", per_cu);
        (void)hipGetLastError();
        grid = cus;
    }
    if (grid < 0) return;
    if (hipMemsetAsync((char*)d_ws + WS_CTL, 0, CTL_ZERO_BYTES, stream) != hipSuccess) return;
    Args a{};
    for (int i = 0; i < NIN; ++i) a.in[i] = (const float*)d_in[i];
    a.out = (float*)d_out; a.ws = (unsigned char*)d_ws;
#if MK_G4TEST
    { static int once = 0; if (!once) { once = 1; if (hipFuncSetAttribute((const void*)gemm4_fwd, hipFuncAttributeMaxDynamicSharedMemorySize, 135168) != hipSuccess) fprintf(stderr, "gemm4 attr failed\n"); } }
    for (int p = 0; p < N_PHASES; ++p) {
        const int k = (p >= 1 && p <= DEPTH * PH_PER_LAYER) ? (p - 1) % PH_PER_LAYER : -1;
        a.ph_lo = p; a.ph_hi = p + 1;
        if (k == 0 || k == 1 || k == 2 || k == 5 || k == 6 || k == 7) hipLaunchKernelGGL(gemm4_fwd, dim3(grid), dim3(256), 135168, stream, a);
        else hipLaunchKernelGGL(mk_fwd, dim3(grid), dim3(NWAVES * 64), LDS_BYTES, stream, a);
    }
#else
    a.ph_lo = 0; a.ph_hi = N_PHASES;
    hipLaunchKernelGGL(mk_fwd, dim3(grid), dim3(NWAVES * 64), LDS_BYTES, stream, a);
#endif
    const hipError_t le = hipPeekAtLastError();
    if (le != hipSuccess) fprintf(stderr, "kernel_launch: launch failed: %s\n", hipGetErrorName(le));
}
```

```cpp
#include <hip/hip_runtime.h>
#include <cstdio>
#include <cstdint>
#include <cmath>
#define MK_NAIVE_A 0
#define MK_NAIVE_B 0
#define MK_PER_PHASE 0
#define MK_DUP_B 0
#define MK_DUP_UP 0
#define MK_DUP_A 0
#define MK_CV_TAIL_LO 2624
#define MK_AUX_RESID 0
#define MK_CIDX ((int)blockIdx.x)
#define MK_ALIGN_UP true
#define MK_B_STAGGER 1
#define MK_PAD_M 0
#define MK_PRIO_L 0
#define MK_PAD_L 0
#define MK_SP2 true
#define MK_ALIGN_RESID true
#define MK_G4TEST 0
#define MK_WT_STORES 0
#define MK_STAG50 0
#define MK_WGM_UP 8
#define MK_DUP_WIN 0
#define MK_DUP_DOWN 0
#define MK_DUP_WOUT 0
#define MK_NT_H 0
#define MK_BH32 1
#define MK_F16 0
#define MK_HI_ONLY 1
#define MK_ATOM2 0
#define MK_RESID_DEPTH 3
namespace pg8 {
#define PG8_LAS __attribute__((address_space(3)))
typedef unsigned short bf16_t;
typedef short bf16x8 __attribute__((ext_vector_type(8)));
typedef float f32x4 __attribute__((ext_vector_type(4)));
typedef unsigned u32x4 __attribute__((ext_vector_type(4)));
constexpr int BM = 256, BK = 64, HALF = 128, HTB = HALF * BK * 2  , STAGE_BYTES = 8 * HTB, NXCD = 8, WGM = 8;

__host__ __device__ __forceinline__ int lds_byte(int r, int c) { const int st = (r >> 4) * 2 + (c >> 5), rr = r & 15, cc = c & 31, ob = rr * 64 + cc * 2; return st * 1024 + (ob ^ (((ob >> 9) & 1) << 5)); }
__host__ __device__ __forceinline__ void stage_rc(int b, int& R, int& C) { const int st = b / 1024, sb = b % 1024, swz = sb ^ (((sb >> 9) & 1) << 5); R = (st >> 1) * 16 + swz / 64; C = (st & 1) * 32 + (swz % 64) / 2; }
__host__ __device__ __forceinline__ int perm32(int rho) { const int n = rho >> 4, i = rho & 15; return 8 * (i >> 2) + 4 * n + (i & 3); }

struct Unit { int pm, pn; };
struct Gemm { const bf16_t* A; const bf16_t* Bt; int M, N, K; };

struct StaticOrder {
    int nM, nN, nwg, G, c, wgm;
    __host__ __device__ void init(int M, int N, int G_, int c_, int wgm_ = WGM) { nM = M / BM; nN = N / BM; nwg = nM * nN; G = G_; c = c_; wgm = wgm_; }
    __host__ __device__ bool next(int i, Unit& u) const {
        const long L = (long)i * G + c; if (L >= nwg) return false;
        int wgid = (int)L; { const int q = nwg / NXCD, r = nwg % NXCD, xcd = wgid % NXCD, off = wgid / NXCD; wgid = (xcd < r ? xcd * (q + 1) : r * (q + 1) + (xcd - r) * q) + off; }
        const int nig = wgm * nN, gid = wgid / nig, fm = gid * wgm, gsz = (nM - fm) < wgm ? (nM - fm) : wgm;
        u.pm = fm + ((wgid % nig) % gsz); u.pn = (wgid % nig) / gsz; return true;
    }
    __device__ __forceinline__ void a_ready(const Unit&) const {}
    __device__ __forceinline__ void done(const Unit&) const {}
};

__device__ __forceinline__ unsigned cvt_pk_bf16(float lo, float hi) { unsigned r; asm volatile("v_cvt_pk_bf16_f32 %0, %1, %2" : "=v"(r) : "v"(lo), "v"(hi)); return r; }
#if MK_F16
typedef _Float16 op16x2 __attribute__((ext_vector_type(2)));
typedef _Float16 op16x8 __attribute__((ext_vector_type(8)));
__device__ __forceinline__ unsigned cvt_pk_op(float lo, float hi) { const op16x2 v = {(_Float16)lo, (_Float16)hi}; return __builtin_bit_cast(unsigned, v); }
__device__ __forceinline__ float op_lo(unsigned u) { return (float)__builtin_bit_cast(op16x2, u)[0]; }
__device__ __forceinline__ float op_hi(unsigned u) { return (float)__builtin_bit_cast(op16x2, u)[1]; }
#define PG8_MFMA_OP(b, a, c) __builtin_amdgcn_mfma_f32_16x16x32_f16(__builtin_bit_cast(pg8::op16x8, b), __builtin_bit_cast(pg8::op16x8, a), c, 0, 0, 0)
#else
__device__ __forceinline__ unsigned cvt_pk_op(float lo, float hi) { return cvt_pk_bf16(lo, hi); }
__device__ __forceinline__ float op_lo(unsigned u) { return __uint_as_float(u << 16); }
__device__ __forceinline__ float op_hi(unsigned u) { return __uint_as_float(u & 0xffff0000u); }
#define PG8_MFMA_OP(b, a, c) __builtin_amdgcn_mfma_f32_16x16x32_bf16(b, a, c, 0, 0, 0)
#endif
__device__ __forceinline__ float silu_mul2(float gp, float up) { return gp * up * __builtin_amdgcn_rcpf(1.0f + __builtin_amdgcn_exp2f(gp)); }
__device__ __forceinline__ float silu_mul(float g, float u) {
    const float e = __builtin_amdgcn_exp2f(-1.4426950408889634f * g);
    return g * u * __builtin_amdgcn_rcpf(1.0f + e);
}
constexpr float EPI_INV_D = 1.0f / 2048.0f, EPI_LN_EPS = 1e-5f;
#ifndef MK_WT_STORES
#define MK_WT_STORES 0
#endif
__device__ __forceinline__ void st16_wt(void* p, const u32x4& v) {
#if MK_WT_STORES
    asm volatile("global_store_dwordx4 %0, %1, off sc1" :: "v"(p), "v"(v) : "memory");
#else
    *(u32x4*)p = v;
#endif
}
typedef long long st_t; typedef int vec_t;
typedef long long i64x2 __attribute__((ext_vector_type(2)));
typedef int i32x4 __attribute__((ext_vector_type(4)));
constexpr float ST_SCALE = 16777216.0f, ST_INV = 1.0f / 16777216.0f, VEC_SCALE = 8388608.0f, VEC_INV = 1.0f / 8388608.0f;
__device__ __forceinline__ st_t st_fix(float v) { return (st_t)__builtin_rintf(v * ST_SCALE); }
__device__ __forceinline__ float st_val(st_t v) { return fmaf((float)(int)(v >> 32), 4294967296.0f, (float)(unsigned)v) * ST_INV; }
__device__ __forceinline__ f32x4 vec4(const vec_t* p) { const i32x4 v = *(const i32x4*)p; return (f32x4){(float)v[0] * VEC_INV, (float)v[1] * VEC_INV, (float)v[2] * VEC_INV, (float)v[3] * VEC_INV}; }
__device__ __forceinline__ void stats_of(const i64x2& s, float& mu, float& rstd) {
    mu = st_val(s[0]) * EPI_INV_D; rstd = __builtin_amdgcn_rsqf(fmaxf(st_val(s[1]) * EPI_INV_D - mu * mu, 0.f) + EPI_LN_EPS);
}
__device__ __forceinline__ void row_stats(const st_t* ST, int row, float& mu, float& rstd) { const i64x2 s = *(const i64x2*)(ST + 2 * (size_t)row); stats_of(s, mu, rstd); }
struct EpiSwigluLN {
    static constexpr bool PERM = true, AFTER_DRAIN = false, BH32 = false;
    bf16_t* H; int ldh; const st_t* ST; const vec_t* cs; const vec_t* bw;
    __device__ __forceinline__ void operator()(const f32x4 (&acc)[2][2][4][2], const Unit& u, int wr, int wc, int fr, int fq) const {
        const int row0 = u.pm * BM + wr * 64 + fr, col0 = u.pn * HALF + wc * 32 + 8 * fq, n0 = u.pn * BM + wc * 32 + 8 * fq;
        f32x4 csv[2][2], bwv[2][2];
#pragma unroll
        for (int bj = 0; bj < 2; ++bj)
#pragma unroll
            for (int n = 0; n < 2; ++n) { csv[bj][n] = vec4(cs + n0 + bj * HALF + 4 * n); bwv[bj][n] = vec4(bw + n0 + bj * HALF + 4 * n) * (bj == 0 ? -1.4426950408889634f : -0.6931471805599453f); }
        i64x2 stv[8];
#pragma unroll
        for (int i = 0; i < 8; ++i) stv[i] = *(const i64x2*)(ST + 2 * (size_t)(row0 + (i >> 2) * HALF + (i & 3) * 16));
#pragma unroll
        for (int ai = 0; ai < 2; ++ai)
#pragma unroll
            for (int m = 0; m < 4; ++m) {
                const int row = row0 + ai * HALF + m * 16;
                float mu, rstd; stats_of(stv[ai * 4 + m], mu, rstd);
                bf16_t* rowp = H + (size_t)row * ldh + col0;
                const float rg = rstd * -1.4426950408889634f, ru = rstd * -0.6931471805599453f;
                const f32x4 g0 = (acc[ai][0][m][0] - csv[0][0] * mu) * rg + bwv[0][0], g1 = (acc[ai][0][m][1] - csv[0][1] * mu) * rg + bwv[0][1];
                const f32x4 u0 = (acc[ai][1][m][0] - csv[1][0] * mu) * ru + bwv[1][0], u1 = (acc[ai][1][m][1] - csv[1][1] * mu) * ru + bwv[1][1];
                u32x4 w;
                w.x = cvt_pk_op(silu_mul2(g0[0], u0[0]), silu_mul2(g0[1], u0[1]));
                w.y = cvt_pk_op(silu_mul2(g0[2], u0[2]), silu_mul2(g0[3], u0[3]));
                w.z = cvt_pk_op(silu_mul2(g1[0], u1[0]), silu_mul2(g1[1], u1[1]));
                w.w = cvt_pk_op(silu_mul2(g1[2], u1[2]), silu_mul2(g1[3], u1[3]));
#if MK_NT_H
                __builtin_nontemporal_store(w, (u32x4*)rowp);
#else
                *(u32x4*)rowp = w;
#endif
            }
    }
};
struct EpiBf16LN {
    static constexpr bool PERM = true, AFTER_DRAIN = false, BH32 = false;
    bf16_t* O; int M; const st_t* ST; const vec_t* cs; const vec_t* bw;
    __device__ __forceinline__ void operator()(const f32x4 (&acc)[2][2][4][2], const Unit& u, int wr, int wc, int fr, int fq) const {
        const int row0 = u.pm * BM + wr * 64 + fr, col0 = u.pn * BM + wc * 32 + 8 * fq;
        f32x4 csv[2][2], bwv[2][2];
#pragma unroll
        for (int bj = 0; bj < 2; ++bj)
#pragma unroll
            for (int n = 0; n < 2; ++n) { csv[bj][n] = vec4(cs + col0 + bj * HALF + 4 * n); bwv[bj][n] = vec4(bw + col0 + bj * HALF + 4 * n); }
        i64x2 stv[8];
#pragma unroll
        for (int i = 0; i < 8; ++i) stv[i] = *(const i64x2*)(ST + 2 * (size_t)(row0 + (i >> 2) * HALF + (i & 3) * 16));
#pragma unroll
        for (int ai = 0; ai < 2; ++ai)
#pragma unroll
            for (int m = 0; m < 4; ++m) {
                const int row = row0 + ai * HALF + m * 16;
                float mu, rstd; stats_of(stv[ai * 4 + m], mu, rstd);
                bf16_t* rowp = O + ((size_t)(u.pn * 2) * M + row) * 128 + wc * 32 + 8 * fq;
#pragma unroll
                for (int bj = 0; bj < 2; ++bj) {
                    const f32x4 v0 = (acc[ai][bj][m][0] - csv[bj][0] * mu) * rstd + bwv[bj][0], v1 = (acc[ai][bj][m][1] - csv[bj][1] * mu) * rstd + bwv[bj][1];
                    u32x4 w; w.x = cvt_pk_bf16(v0[0], v0[1]); w.y = cvt_pk_bf16(v0[2], v0[3]); w.z = cvt_pk_bf16(v1[0], v1[1]); w.w = cvt_pk_bf16(v1[2], v1[3]);
                    *(u32x4*)(rowp + (size_t)bj * M * 128) = w;
                }
            }
    }
};
typedef unsigned u32x2 __attribute__((ext_vector_type(2)));
constexpr float LO_SCALE = 2048.0f, LO_INV = 1.0f / 2048.0f;
struct ResidLoads { u32x4 h0, h1; u32x2 l0, l1; i64x2 st; };
__device__ __forceinline__ f32x4 bf_lo4(const u32x4& h, const u32x2& l, int half) {
    const unsigned ha = h[2 * half], hb = h[2 * half + 1];
#if MK_HI_ONLY
    return (f32x4){op_lo(ha), op_hi(ha), op_lo(hb), op_hi(hb)};
#else
    const auto la = __builtin_amdgcn_cvt_pk_f32_fp8((int)l[half], false), lb = __builtin_amdgcn_cvt_pk_f32_fp8((int)l[half], true);
    return (f32x4){fmaf(la[0], LO_INV, op_lo(ha)), fmaf(la[1], LO_INV, op_hi(ha)),
                   fmaf(lb[0], LO_INV, op_lo(hb)), fmaf(lb[1], LO_INV, op_hi(hb))};
#endif
}
struct EpiResidLN {
    static constexpr bool PERM = true, AFTER_DRAIN = false, BH32 = (MK_BH32 != 0);
    static constexpr int CH = BH32 ? 32 : HALF, WCS = BH32 ? 64 : 32;
    bf16_t* YH; unsigned char* YL; bf16_t* YHo; unsigned char* YLo; int ldc; const st_t* STp; st_t* STn; const float* gp; const float* bp; float alpha, coef;
    __device__ __forceinline__ void issue(ResidLoads& L, int row, int col0) const {
        const size_t o = (size_t)row * ldc + col0;
        L.st = *(const i64x2*)(STp + 2 * (size_t)row);
        L.h0 = *(const u32x4*)(YH + o); L.h1 = *(const u32x4*)(YH + o + CH);
#if !MK_HI_ONLY
        L.l0 = *(const u32x2*)(YL + o); L.l1 = *(const u32x2*)(YL + o + CH);
#endif
    }
    __device__ __forceinline__ void split_store(bf16_t* ph, unsigned char* pl, const f32x4& a, const f32x4& b) const {
        u32x4 h; u32x2 l;
        h.x = cvt_pk_op(a[0], a[1]); h.y = cvt_pk_op(a[2], a[3]); h.z = cvt_pk_op(b[0], b[1]); h.w = cvt_pk_op(b[2], b[3]);
#if !MK_HI_ONLY
        int w0 = __builtin_amdgcn_cvt_pk_fp8_f32((a[0] - op_lo(h.x)) * LO_SCALE, (a[1] - op_hi(h.x)) * LO_SCALE, 0, false);
        w0 = __builtin_amdgcn_cvt_pk_fp8_f32((a[2] - op_lo(h.y)) * LO_SCALE, (a[3] - op_hi(h.y)) * LO_SCALE, w0, true);
        int w1 = __builtin_amdgcn_cvt_pk_fp8_f32((b[0] - op_lo(h.z)) * LO_SCALE, (b[1] - op_hi(h.z)) * LO_SCALE, 0, false);
        w1 = __builtin_amdgcn_cvt_pk_fp8_f32((b[2] - op_lo(h.w)) * LO_SCALE, (b[3] - op_hi(h.w)) * LO_SCALE, w1, true);
        l.x = (unsigned)w0; l.y = (unsigned)w1;
#endif
        *(u32x4*)ph = h;
#if !MK_HI_ONLY
        *(u32x2*)pl = l;
#endif
    }
    __device__ __forceinline__ void finish(const ResidLoads& L, int row, int col0, const f32x4& a00, const f32x4& a01, const f32x4& a10, const f32x4& a11,
                                           const f32x4 (&gv)[2][2], const f32x4 (&bv)[2][2], float& s, float& q) const {
        float mu, rstd; stats_of(L.st, mu, rstd);
        const size_t o = (size_t)row * ldc + col0;
        const f32x4 v00 = (bf_lo4(L.h0, L.l0, 0) - mu) * rstd * gv[0][0] + bv[0][0] + a00 * coef, v01 = (bf_lo4(L.h0, L.l0, 1) - mu) * rstd * gv[0][1] + bv[0][1] + a01 * coef;
        const f32x4 v10 = (bf_lo4(L.h1, L.l1, 0) - mu) * rstd * gv[1][0] + bv[1][0] + a10 * coef, v11 = (bf_lo4(L.h1, L.l1, 1) - mu) * rstd * gv[1][1] + bv[1][1] + a11 * coef;
        split_store(YHo + o, YLo + o, v00, v01); split_store(YHo + o + CH, YLo + o + CH, v10, v11);
        const f32x4 t = (v00 + v01) + (v10 + v11), t2 = (v00 * v00 + v01 * v01) + (v10 * v10 + v11 * v11);
        s = (t[0] + t[1]) + (t[2] + t[3]); q = (t2[0] + t2[1]) + (t2[2] + t2[3]);
        s += __shfl_xor(s, 16); s += __shfl_xor(s, 32); q += __shfl_xor(q, 16); q += __shfl_xor(q, 32);
    }
    __device__ __forceinline__ void operator()(const f32x4 (&acc)[2][2][4][2], const Unit& u, int wr, int wc, int fr, int fq) const {
        const int row0 = u.pm * BM + wr * 64 + fr, col0 = u.pn * BM + wc * WCS + 8 * fq;
#if MK_RESID_DEPTH == 3
        ResidLoads LQ[3];
#define RESID_ROW(i) (row0 + ((i) >> 2) * HALF + ((i) & 3) * 16)
        issue(LQ[0], row0, col0); issue(LQ[1], RESID_ROW(1), col0);
        f32x4 gv[2][2], bv[2][2];
#pragma unroll
        for (int bj = 0; bj < 2; ++bj)
#pragma unroll
            for (int n = 0; n < 2; ++n) { gv[bj][n] = *(const f32x4*)(gp + col0 + bj * CH + 4 * n) * alpha; bv[bj][n] = *(const f32x4*)(bp + col0 + bj * CH + 4 * n) * alpha; }
        float s_lo = 0.f, q_lo = 0.f, s_hi = 0.f, q_hi = 0.f;
#pragma unroll
        for (int i = 0; i < 8; ++i) {
            if (i + 2 < 8) issue(LQ[(i + 2) % 3], RESID_ROW(i + 2), col0);
            asm volatile("" ::: "memory");
            float s_, q_;
            finish(LQ[i % 3], RESID_ROW(i), col0, acc[i >> 2][0][i & 3][0], acc[i >> 2][0][i & 3][1], acc[i >> 2][1][i & 3][0], acc[i >> 2][1][i & 3][1], gv, bv, s_, q_);
            if (i < 4) { s_lo = fq == (i & 3) ? s_ : s_lo; q_lo = fq == (i & 3) ? q_ : q_lo; } else { s_hi = fq == (i & 3) ? s_ : s_hi; q_hi = fq == (i & 3) ? q_ : q_hi; }
            asm volatile("" ::: "memory");
        }
#undef RESID_ROW
#else
        ResidLoads LA, LB;
        issue(LA, row0, col0);
        f32x4 gv[2][2], bv[2][2];
#pragma unroll
        for (int bj = 0; bj < 2; ++bj)
#pragma unroll
            for (int n = 0; n < 2; ++n) { gv[bj][n] = *(const f32x4*)(gp + col0 + bj * CH + 4 * n) * alpha; bv[bj][n] = *(const f32x4*)(bp + col0 + bj * CH + 4 * n) * alpha; }
        float rs[8], rq[8];
#define RESID_ROW(i) (row0 + ((i) >> 2) * HALF + ((i) & 3) * 16)
#pragma unroll
        for (int i = 0; i < 8; i += 2) {
            issue(LB, RESID_ROW(i + 1), col0);
            asm volatile("" ::: "memory");
            finish(LA, RESID_ROW(i), col0, acc[i >> 2][0][i & 3][0], acc[i >> 2][0][i & 3][1], acc[i >> 2][1][i & 3][0], acc[i >> 2][1][i & 3][1], gv, bv, rs[i], rq[i]);
            asm volatile("" ::: "memory");
            if (i + 2 < 8) issue(LA, RESID_ROW(i + 2), col0);
            asm volatile("" ::: "memory");
            finish(LB, RESID_ROW(i + 1), col0, acc[(i + 1) >> 2][0][(i + 1) & 3][0], acc[(i + 1) >> 2][0][(i + 1) & 3][1], acc[(i + 1) >> 2][1][(i + 1) & 3][0], acc[(i + 1) >> 2][1][(i + 1) & 3][1], gv, bv, rs[i + 1], rq[i + 1]);
            asm volatile("" ::: "memory");
        }
#undef RESID_ROW
        const float s_lo = fq == 0 ? rs[0] : fq == 1 ? rs[1] : fq == 2 ? rs[2] : rs[3], q_lo = fq == 0 ? rq[0] : fq == 1 ? rq[1] : fq == 2 ? rq[2] : rq[3];
        const float s_hi = fq == 0 ? rs[4] : fq == 1 ? rs[5] : fq == 2 ? rs[6] : rs[7], q_hi = fq == 0 ? rq[4] : fq == 1 ? rq[5] : fq == 2 ? rq[6] : rq[7];
#endif
        st_t* p_lo = STn + 2 * (size_t)(row0 + fq * 16), * p_hi = STn + 2 * (size_t)(row0 + HALF + fq * 16);
        __hip_atomic_fetch_add(p_lo, st_fix(s_lo), __ATOMIC_RELAXED, __HIP_MEMORY_SCOPE_AGENT); __hip_atomic_fetch_add(p_lo + 1, st_fix(q_lo), __ATOMIC_RELAXED, __HIP_MEMORY_SCOPE_AGENT);
        __hip_atomic_fetch_add(p_hi, st_fix(s_hi), __ATOMIC_RELAXED, __HIP_MEMORY_SCOPE_AGENT); __hip_atomic_fetch_add(p_hi + 1, st_fix(q_hi), __ATOMIC_RELAXED, __HIP_MEMORY_SCOPE_AGENT);
    }
};
struct EpiNull {
    static constexpr bool PERM = true, AFTER_DRAIN = false, BH32 = false;
    __device__ __forceinline__ void operator()(const f32x4 (&acc)[2][2][4][2], const Unit&, int, int, int, int) const {
#pragma unroll
        for (int ai = 0; ai < 2; ++ai)
#pragma unroll
            for (int bj = 0; bj < 2; ++bj)
#pragma unroll
                for (int m = 0; m < 4; ++m)
#pragma unroll
                    for (int n = 0; n < 2; ++n) asm volatile("" :: "v"(acc[ai][bj][m][n]));
    }
};
template <class Epi, class Sched, bool ALIGN_EPI = false, bool SP2 = false, int AUX_A = 0  >
__device__ __forceinline__ void gemm_phase(PG8_LAS unsigned char* lds, const Gemm g, const Sched& S, const Epi& E) {
    int tid_ = threadIdx.x; asm volatile("" : "+v"(tid_));
    const int tid = tid_, wid = __builtin_amdgcn_readfirstlane(tid >> 6), lane = tid & 63, wr = wid >> 2, wc = wid & 3, fr = lane & 15, fq = lane >> 4;
    const int K = g.K, nt = K / BK;
    unsigned voffA[2], voffB[2];
#pragma unroll
    for (int i = 0; i < 2; ++i) { int R, C; stage_rc(tid * 16 + i * 8192, R, C); const int Rb = Epi::BH32 ? ((R >> 5) * 64 + perm32(R & 31)) : Epi::PERM ? ((R & ~31) + perm32(R & 31)) : R;
        voffA[i] = (unsigned)(R * K + C) * 2u; voffB[i] = (unsigned)(Rb * K + C) * 2u; }
    const size_t kstep = (size_t)(BK * 2);
    const size_t hstep = (size_t)HALF * K * 2;
    const size_t tstep = 2 * hstep;
    const size_t bhs = Epi::BH32 ? (size_t)32 * K * 2 : hstep;
    const unsigned ldsw = (unsigned)wid * 1024u;
    const int aoff = lds_byte(wr * 64 + fr, fq * 8), boff = lds_byte(wc * 32 + fr, fq * 8);
#define PG8_SA(b, h) (((b) * 2 + (h)) * HTB)
#define PG8_SB(b, h) ((4 + (b) * 2 + (h)) * HTB)
#define PG8_STAGE_X(bufoff, gbase, voff, aux) do { _Pragma("unroll") for (int _i = 0; _i < 2; ++_i) \
        __builtin_amdgcn_global_load_lds((const unsigned*)((const char*)(gbase) + (voff)[_i]), (PG8_LAS unsigned*)(lds + (bufoff) + ldsw + _i * 8192), 16, 0, (aux)); } while (0)
#define PG8_LDA(dst, b, h) do { _Pragma("unroll") for (int m = 0; m < 4; ++m) _Pragma("unroll") for (int k = 0; k < 2; ++k) dst[m][k] = *(const PG8_LAS bf16x8*)(lds + PG8_SA(b, h) + aoff + m * 2048 + k * 1024); } while (0)
#define PG8_LDB(dst, b, h) do { _Pragma("unroll") for (int n = 0; n < 2; ++n) _Pragma("unroll") for (int k = 0; k < 2; ++k) dst[n][k] = *(const PG8_LAS bf16x8*)(lds + PG8_SB(b, h) + boff + n * 2048 + k * 1024); } while (0)
#define PG8_MMA(ai, bj, At, Bt) do { __builtin_amdgcn_s_setprio(1); _Pragma("unroll") for (int m = 0; m < 4; ++m) _Pragma("unroll") for (int n = 0; n < 2; ++n) _Pragma("unroll") for (int k = 0; k < 2; ++k) \
        acc[ai][bj][m][n] = PG8_MFMA_OP(Bt[n][k], At[m][k], acc[ai][bj][m][n]); __builtin_amdgcn_s_setprio(0); } while (0)
#define PG8_WAIT_V(n) asm volatile("s_waitcnt vmcnt(" #n ")" ::: "memory")
#define PG8_WAIT_L(n) asm volatile("s_waitcnt lgkmcnt(" #n ")" ::: "memory")
#define PG8_BAR __builtin_amdgcn_s_barrier()
#define PG8_SCHED __builtin_amdgcn_sched_barrier(0)
    Unit cur, nxt; int ui = 0;
    if (!S.next(0, cur)) return;
    f32x4 acc[2][2][4][2];
#pragma unroll
    for (int a = 0; a < 2; ++a)
#pragma unroll
        for (int b = 0; b < 2; ++b)
#pragma unroll
            for (int m = 0; m < 4; ++m)
#pragma unroll
                for (int n = 0; n < 2; ++n) acc[a][b][m][n] = (f32x4){0.f, 0.f, 0.f, 0.f};
    bf16x8 At[4][2], B0[2][2], B1[2][2];
    const char* cA = (const char*)g.A + (size_t)cur.pm * tstep; const char* cB = (const char*)g.Bt + (size_t)cur.pn * tstep;
    S.a_ready(cur);
    if constexpr (SP2) {
        PG8_STAGE_X(PG8_SB(0, 0), cB, voffB, 0); PG8_STAGE_X(PG8_SB(0, 1), cB + bhs, voffB, 0); PG8_STAGE_X(PG8_SA(0, 0), cA, voffA, AUX_A); PG8_STAGE_X(PG8_SA(0, 1), cA + hstep, voffA, AUX_A);
        if (wr == 1) PG8_BAR;
        PG8_WAIT_V(2); PG8_BAR;
        PG8_STAGE_X(PG8_SB(1, 0), cB + kstep, voffB, 0); PG8_STAGE_X(PG8_SA(1, 0), cA + kstep, voffA, AUX_A); PG8_STAGE_X(PG8_SB(1, 1), cB + bhs + kstep, voffB, 0);
        PG8_WAIT_V(6); PG8_BAR;
    } else {
        PG8_STAGE_X(PG8_SB(0, 0), cB, voffB, 0); PG8_STAGE_X(PG8_SA(0, 0), cA, voffA, AUX_A); PG8_STAGE_X(PG8_SB(0, 1), cB + bhs, voffB, 0); PG8_STAGE_X(PG8_SA(0, 1), cA + hstep, voffA, AUX_A);
        if (wr == 1) PG8_BAR;
        PG8_WAIT_V(4); PG8_BAR;
        PG8_STAGE_X(PG8_SB(1, 0), cB + kstep, voffB, 0); PG8_STAGE_X(PG8_SA(1, 0), cA + kstep, voffA, AUX_A); PG8_STAGE_X(PG8_SB(1, 1), cB + bhs + kstep, voffB, 0);
        PG8_WAIT_V(6); PG8_BAR;
    }
    for (;;) {
        const bool has_next = S.next(ui + 1, nxt);
        const char* nA = has_next ? (const char*)g.A + (size_t)nxt.pm * tstep : cA; const char* nB = has_next ? (const char*)g.Bt + (size_t)nxt.pn * tstep : cB;
        for (int t = 0; t < nt; t += 2) {
            const bool last = (t == nt - 2);
            const char* a1 = cA + (size_t)(t + 1) * kstep;
            const char* a2 = last ? nA : cA + (size_t)(t + 2) * kstep; const char* b2 = last ? nB : cB + (size_t)(t + 2) * kstep;
            const char* a3 = a2 + kstep; const char* b3 = b2 + kstep;
            if (last && has_next) S.a_ready(nxt);
            if constexpr (SP2) {
            PG8_LDB(B0, 0, 0); PG8_LDB(B1, 0, 1); PG8_SCHED; PG8_LDA(At, 0, 0); PG8_STAGE_X(PG8_SA(1, 1), a1 + hstep, voffA, AUX_A);
            PG8_WAIT_V(8); PG8_WAIT_L(0); PG8_BAR; PG8_MMA(0, 0, At, B0); PG8_MMA(0, 1, At, B1); PG8_BAR; PG8_SCHED;
            PG8_LDA(At, 0, 1); PG8_STAGE_X(PG8_SB(0, 0), b2, voffB, 0); PG8_STAGE_X(PG8_SB(0, 1), b2 + bhs, voffB, 0); PG8_STAGE_X(PG8_SA(0, 0), a2, voffA, AUX_A);
            PG8_WAIT_V(8); PG8_WAIT_L(0); PG8_BAR; PG8_MMA(1, 0, At, B0); PG8_MMA(1, 1, At, B1); PG8_BAR; PG8_SCHED;
            PG8_LDB(B0, 1, 0); PG8_LDB(B1, 1, 1); PG8_SCHED; PG8_LDA(At, 1, 0); PG8_STAGE_X(PG8_SA(0, 1), a2 + hstep, voffA, AUX_A);
            PG8_WAIT_V(8); PG8_WAIT_L(0); PG8_BAR; PG8_MMA(0, 0, At, B0); PG8_MMA(0, 1, At, B1); PG8_BAR; PG8_SCHED;
            PG8_LDA(At, 1, 1); PG8_STAGE_X(PG8_SB(1, 0), b3, voffB, 0); PG8_STAGE_X(PG8_SB(1, 1), b3 + bhs, voffB, 0); PG8_STAGE_X(PG8_SA(1, 0), a3, voffA, AUX_A);
            PG8_WAIT_V(8); PG8_WAIT_L(0); PG8_BAR; PG8_MMA(1, 0, At, B0); PG8_MMA(1, 1, At, B1); PG8_BAR; PG8_SCHED;
            } else {
            PG8_LDB(B0, 0, 0); PG8_SCHED; PG8_LDA(At, 0, 0); PG8_STAGE_X(PG8_SA(1, 1), a1 + hstep, voffA, AUX_A);
            PG8_WAIT_L(8); PG8_BAR; PG8_WAIT_L(0); PG8_MMA(0, 0, At, B0); PG8_BAR; PG8_SCHED;
            PG8_LDB(B1, 0, 1); PG8_STAGE_X(PG8_SB(0, 0), b2, voffB, 0);
            PG8_BAR; PG8_WAIT_L(0); PG8_MMA(0, 1, At, B1); PG8_BAR;
            PG8_LDA(At, 0, 1); PG8_STAGE_X(PG8_SA(0, 0), a2, voffA, AUX_A);
            PG8_BAR; PG8_WAIT_L(0); PG8_MMA(1, 0, At, B0); PG8_BAR; PG8_SCHED;
            PG8_STAGE_X(PG8_SB(0, 1), b2 + bhs, voffB, 0);
            PG8_WAIT_V(6); PG8_BAR; PG8_MMA(1, 1, At, B1); PG8_BAR;
            PG8_LDB(B0, 1, 0); PG8_SCHED; PG8_LDA(At, 1, 0); PG8_STAGE_X(PG8_SA(0, 1), a2 + hstep, voffA, AUX_A);
            PG8_WAIT_L(8); PG8_BAR; PG8_WAIT_L(0); PG8_MMA(0, 0, At, B0); PG8_BAR; PG8_SCHED;
            PG8_LDB(B1, 1, 1); PG8_STAGE_X(PG8_SB(1, 0), b3, voffB, 0);
            PG8_BAR; PG8_WAIT_L(0); PG8_MMA(0, 1, At, B1); PG8_BAR;
            PG8_LDA(At, 1, 1); PG8_STAGE_X(PG8_SA(1, 0), a3, voffA, AUX_A);
            PG8_BAR; PG8_WAIT_L(0); PG8_MMA(1, 0, At, B0); PG8_BAR; PG8_SCHED;
            PG8_STAGE_X(PG8_SB(1, 1), b3 + bhs, voffB, 0);
            PG8_WAIT_V(6); PG8_BAR; PG8_MMA(1, 1, At, B1); PG8_BAR;
            }
        }
        if constexpr (ALIGN_EPI) { if (wr == 0) PG8_BAR; }
        if constexpr (!Epi::AFTER_DRAIN) { E(acc, cur, wr, wc, fr, fq); S.done(cur); }
        if (!has_next) break;
#pragma unroll
        for (int a = 0; a < 2; ++a)
#pragma unroll
            for (int b = 0; b < 2; ++b)
#pragma unroll
                for (int m = 0; m < 4; ++m)
#pragma unroll
                    for (int n = 0; n < 2; ++n) acc[a][b][m][n] = (f32x4){0.f, 0.f, 0.f, 0.f};
        cur = nxt; cA = nA; cB = nB; ++ui;
        if constexpr (ALIGN_EPI) { if (wr == 1) PG8_BAR; }
    }
    PG8_WAIT_V(0);
    if constexpr (!ALIGN_EPI) { if (wr == 0) PG8_BAR; }
    PG8_BAR;
    if constexpr (Epi::AFTER_DRAIN) { E.fused(acc, cur, wr, wc, fr, fq, lds, wid, lane); S.done(cur); }
#undef PG8_SA
#undef PG8_SB
#undef PG8_STAGE_X
#undef PG8_LDA
#undef PG8_LDB
#undef PG8_MMA
#undef PG8_WAIT_V
#undef PG8_WAIT_L
#undef PG8_BAR
#undef PG8_SCHED
}
}
#define GAS __attribute__((address_space(1)))
#define LAS __attribute__((address_space(3)))
typedef unsigned short bf16;
typedef unsigned v4u __attribute__((ext_vector_type(4)));
typedef float f32x4 __attribute__((ext_vector_type(4)));
typedef short bf16x8 __attribute__((ext_vector_type(8)));
typedef GAS unsigned gu32;
typedef GAS unsigned long long gu64;
#define RLX_AGENT __ATOMIC_RELAXED, __HIP_MEMORY_SCOPE_AGENT
#define LDS_WAIT() asm volatile("s_waitcnt lgkmcnt(0)" ::: "memory")
#define VM_WAIT() asm volatile("s_waitcnt vmcnt(0)" ::: "memory")
__device__ __forceinline__ unsigned long long rt() { return __builtin_amdgcn_s_memrealtime(); }
__device__ __forceinline__ unsigned f2bf(float f) { unsigned u = __builtin_bit_cast(unsigned, f); return (u + 0x7fffu + ((u >> 16) & 1u)) >> 16; }
__device__ __forceinline__ unsigned pk2(float lo, float hi) { return f2bf(lo) | (f2bf(hi) << 16); }

#define XB_TMO      128
#define XB_XCNT(j)  (256  + 64 * (j))
#define XB_XSUB(j)  (1280 + 64 * (j))
#define XB_XGEN(j)  (2304 + 64 * (j))
#define XB_TOP      3328
#define XB_TOPGEN   3392
#define XCD_BAR_WORDS 3456
#define XB_SPIN_CAP (1u << 18)

__device__ __forceinline__ unsigned xb_ld(unsigned* p)              { return __hip_atomic_load(p, __ATOMIC_RELAXED, __HIP_MEMORY_SCOPE_AGENT); }
__device__ __forceinline__ unsigned xb_add(unsigned* p, unsigned v) { return __hip_atomic_fetch_add(p, v, __ATOMIC_RELAXED, __HIP_MEMORY_SCOPE_AGENT); }
__device__ __forceinline__ unsigned xb_xcc_id() { return (unsigned)__builtin_amdgcn_s_getreg((3 << 11) | 20) & 0xFu; }
#define XB_SPIN(cond, bar) do { unsigned _sp = 0; while (cond) { __builtin_amdgcn_s_sleep(1); \
    if ((++_sp & 255u) == 0u) { if (xb_ld(&(bar)[XB_TMO])) break; if (_sp > XB_SPIN_CAP) { atomicAdd(&(bar)[XB_TMO], 1u); break; } } } } while (0)

struct XcdBarrier {
    unsigned* bar; unsigned x;
    volatile LAS unsigned* st;
};

__device__ __forceinline__ XcdBarrier xcd_barrier_post(unsigned* bar, volatile LAS unsigned* st) {
    XcdBarrier b; b.bar = bar; b.x = xb_xcc_id(); b.st = st;
    if (threadIdx.x == 0) (void)xb_add(&bar[XB_XCNT(b.x)], 1u);
    return b;
}
__device__ __forceinline__ void xcd_barrier_complete(unsigned* bar, unsigned x, unsigned& nloc, unsigned& nx) {
    const unsigned G = gridDim.x * gridDim.y * gridDim.z;
    unsigned sum, cnt, mine, sp = 0u;
    for (;;) {
        sum = 0u; cnt = 0u; mine = 0u;
#pragma unroll
        for (unsigned j = 0; j < 16; ++j) { const unsigned c = xb_ld(&bar[XB_XCNT(j)]); sum += c; cnt += (c > 0u) ? 1u : 0u; mine = (j == x) ? c : mine; }
        if (sum == G) break;
        __builtin_amdgcn_s_sleep(1);
        if ((++sp & 255u) == 0u) { if (xb_ld(&bar[XB_TMO])) break; if (sp > XB_SPIN_CAP) { atomicAdd(&bar[XB_TMO], 1u); break; } }
    }
    nloc = mine > 0u ? mine : 1u; nx = cnt > 0u ? cnt : 1u;
}

__device__ __forceinline__ void xcd_barrier(const XcdBarrier& b) {
    asm volatile("s_waitcnt vmcnt(0)" ::: "memory");
    __syncthreads();
    if (threadIdx.x == 0) {
        unsigned* bar = b.bar;
        __builtin_amdgcn_s_waitcnt(0);
        unsigned nloc = b.st[0], nx = b.st[1];
        if (nloc == 0u) { xcd_barrier_complete(bar, b.x, nloc, nx); b.st[0] = nloc; b.st[1] = nx; }
        const unsigned old = xb_add(&bar[XB_XSUB(b.x)], 1u);
        const unsigned gen = old / nloc;
        if (old + 1u == (gen + 1u) * nloc) {
            __builtin_amdgcn_fence(__ATOMIC_RELEASE, "agent");
            asm volatile("s_waitcnt vmcnt(0)" ::: "memory");
            const unsigned og = xb_add(&bar[XB_TOP], 1u);
            const unsigned tg = og / nx;
            if (og + 1u == (tg + 1u) * nx) xb_add(&bar[XB_TOPGEN], 1u);
            else XB_SPIN(xb_ld(&bar[XB_TOPGEN]) == tg, bar);
            __builtin_amdgcn_fence(__ATOMIC_ACQUIRE, "agent");
            xb_add(&bar[XB_XGEN(b.x)], 1u);
            asm volatile("s_waitcnt vmcnt(0)" ::: "memory");
        } else {
            XB_SPIN(xb_ld(&bar[XB_XGEN(b.x)]) == gen, bar);
            __builtin_amdgcn_fence(__ATOMIC_ACQUIRE, "agent");
            asm volatile("s_waitcnt vmcnt(0)" ::: "memory");
        }
    }
    __syncthreads();
}
constexpr int NWAVES = 8;
constexpr int DM = 2048, DFF = 5632, NFF2 = 2 * DFF, NTOK = 24576, INW = 6144, DEPTH = 4, NIN = 22;
constexpr int S_PROMPT = 8192, S_SAMPLE = 4096;
constexpr float ALPHA = 1.6817928305074290f;
constexpr float LN_EPS = 1e-5f, RMS_EPS = 1e-6f;
constexpr size_t MiB = 1u << 20;
constexpr size_t WS_CTL = 0, WS_VEC = 1 * MiB, CTL_ZERO_BYTES = 2 * MiB;
constexpr int V_CS1 = 0, V_BW1 = NFF2, V_CSIN = 2 * NFF2, V_BWIN = V_CSIN + INW, V_CS2 = V_BWIN + INW, V_BW2 = V_CS2 + NFF2, V_LAYER = V_BW2 + NFF2;
static_assert((size_t)DEPTH * V_LAYER * 4 <= 1 * MiB, "vec");
constexpr size_t WS_ST = 2 * MiB;
constexpr size_t WS_ID = WS_ST + (size_t)2 * NTOK * 2 * 8;
static_assert(WS_ID + 2 * DM * 4 <= 4 * MiB, "st");
constexpr size_t SZ_W1 = (size_t)NFF2 * DM * 2, SZ_WD = (size_t)DM * DFF * 2, SZ_WIN = (size_t)INW * DM * 2, SZ_WOUT = (size_t)DM * DM * 2;
constexpr size_t OFF_W1A = 0, OFF_WD1 = OFF_W1A + SZ_W1, OFF_WIN = OFF_WD1 + SZ_WD, OFF_WOUT = OFF_WIN + SZ_WIN, OFF_W2A = OFF_WOUT + SZ_WOUT, OFF_WD2 = OFF_W2A + SZ_W1;
constexpr size_t SZ_LAYER = OFF_WD2 + SZ_WD;
constexpr size_t WS_W = 4 * MiB;
constexpr size_t SZ_XN = (size_t)NTOK * DM * 2;
constexpr size_t WS_XN = WS_W + DEPTH * SZ_LAYER;
constexpr size_t WS_Y = WS_XN + SZ_XN;
constexpr size_t WS_QKV = WS_Y + SZ_XN;
constexpr size_t SZ_QKV = (size_t)NTOK * INW * 2;
constexpr size_t WS_OA = WS_QKV + SZ_QKV;
constexpr size_t SZ_OA1 = (size_t)NTOK * 1024 * 2;
constexpr size_t WS_LSE = WS_OA + 3 * SZ_OA1;
constexpr size_t SZ_LSE1 = (size_t)NTOK * 8 * 4;
constexpr size_t WS_YL = WS_LSE + 3 * SZ_LSE1;
constexpr size_t WS_END = WS_YL + SZ_XN / 2;
constexpr int CW_TMO = 0, CW_CODE = 1, CW_BAR = 4096;
constexpr int CW_KN = 8192;
constexpr int CW_QH = 16384;
static_assert((CW_BAR + XCD_BAR_WORDS) * 4 <= (int)CTL_ZERO_BYTES, "ctl");
constexpr int RING_OFF = 0, RING_BYTES = 131072;
constexpr int LDSCTL_OFF = RING_BYTES, MISC_OFF = LDSCTL_OFF + 320;
constexpr int LDS_BYTES = 147456;
constexpr int KNL_OFF = LDSCTL_OFF + 1024;
constexpr int PH_PER_LAYER = 8, N_PHASES = 2 + DEPTH * PH_PER_LAYER;

struct Frame {
    LAS unsigned char* lds;
    volatile LAS unsigned* MISC;
    gu32* ctl;
    int wave, vcu, G;
};
__device__ __forceinline__ int ftid() { int t = threadIdx.x; asm volatile("" : "+v"(t)); return t; }
__device__ __forceinline__ int flane() { return ftid() & 63; }
__device__ __forceinline__ float wave_sum(float v) {
#pragma unroll
    for (int o = 1; o < 64; o <<= 1) v += __shfl_xor(v, o);
    return v;
}
__device__ __forceinline__ float bf2f(bf16 v) { return __uint_as_float((unsigned)v << 16); }
__device__ __forceinline__ void seq_of(int tok, int& base, int& S) { if (tok < S_PROMPT) { base = 0; S = S_PROMPT; } else { base = S_PROMPT + (((tok - S_PROMPT) >> 12) << 12); S = S_SAMPLE; } }

__device__ const unsigned short B_UNITS[1792] = {1536,1537,1538,1539,1540,1541,1542,1543,1544,1545,1546,1547,1548,1549,1550,1551,1552,1553,1554,1555,1556,1557,1558,1559,1560,1561,1562,1563,1564,1565,1566,1567,13568,13569,13570,28672,13571,13572,13573,28673,13574,13575,13576,28674,13577,13578,13579,28675,13580,13581,13582,28676,13583,13584,13585,28677,13586,13587,13588,28678,13589,13590,13591,28679,13592,13593,13594,28680,13595,13596,13597,28681,13598,13599,5120,28682,5121,5122,5123,28683,5124,5125,5126,28684,5127,5128,5129,28685,5130,5131,5132,28686,5133,5134,5135,28687,5136,5137,5138,28688,5139,5140,5141,28689,5142,5143,5144,28690,5145,5146,5147,28691,5148,5149,5150,28692,5151,4608,4609,28693,4610,4611,4612,28694,4613,4614,4615,28695,4616,4617,4618,28696,4619,4620,4621,28697,4622,4623,4624,28698,4625,4626,4627,28699,4628,4629,4630,28700,4631,4632,4633,28701,4634,4635,4636,28702,4637,4638,4639,28703,0,1,2,3,4,5,6,7,8,9,10,11,12,13,14,15,16,17,18,19,20,21,22,23,24,25,26,27,28,29,30,31,1568,1569,1570,1571,1572,1573,1574,1575,1576,1577,1578,1579,1580,1581,1582,1583,1584,1585,1586,1587,1588,1589,1590,1591,1592,1593,1594,1595,1596,1597,1598,1599,13824,13825,13826,28704,13827,13828,13829,28705,13830,13831,13832,28706,13833,13834,13835,28707,13836,13837,13838,28708,13839,13840,13841,28709,13842,13843,13844,28710,13845,13846,13847,28711,13848,13849,13850,28712,13851,13852,13853,28713,13854,13855,9216,28714,9217,9218,9219,28715,9220,9221,9222,28716,9223,9224,9225,28717,9226,9227,9228,28718,9229,9230,9231,28719,9232,9233,9234,28720,9235,9236,9237,28721,9238,9239,9240,28722,9241,9242,9243,28723,9244,9245,9246,28724,9247,8704,8705,28725,8706,8707,8708,28726,8709,8710,8711,28727,8712,8713,8714,28728,8715,8716,8717,28729,8718,8719,8720,28730,8721,8722,8723,28731,8724,8725,8726,28732,8727,8728,8729,28733,8730,8731,8732,28734,8733,8734,8735,28735,32,33,34,35,36,37,38,39,40,41,42,43,44,45,46,47,48,49,50,51,52,53,54,55,56,57,58,59,60,61,62,63,1792,1793,1794,1795,1796,1797,1798,1799,1800,1801,1802,1803,1804,1805,1806,1807,1808,1809,1810,1811,1812,1813,1814,1815,1816,1817,1818,1819,1820,1821,1822,1823,14080,14081,14082,28736,14083,14084,14085,28737,14086,14087,14088,28738,14089,14090,14091,28739,14092,14093,14094,28740,14095,14096,14097,28741,14098,14099,14100,28742,14101,14102,14103,28743,14104,14105,14106,28744,14107,14108,14109,28745,14110,14111,13312,28746,13313,13314,13315,28747,13316,13317,13318,28748,13319,13320,13321,28749,13322,13323,13324,28750,13325,13326,13327,28751,13328,13329,13330,28752,13331,13332,13333,28753,13334,13335,13336,28754,13337,13338,13339,28755,13340,13341,13342,28756,13343,12800,12801,28757,12802,12803,12804,28758,12805,12806,12807,28759,12808,12809,12810,28760,12811,12812,12813,28761,12814,12815,12816,28762,12817,12818,12819,28763,12820,12821,12822,28764,12823,12824,12825,28765,12826,12827,12828,28766,12829,12830,12831,28767,4096,4097,4098,4099,4100,4101,4102,4103,4104,4105,4106,4107,4108,4109,4110,4111,4112,4113,4114,4115,4116,4117,4118,4119,4120,4121,4122,4123,4124,4125,4126,4127,1824,1825,1826,1827,1828,1829,1830,1831,1832,1833,1834,1835,1836,1837,1838,1839,1840,1841,1842,1843,1844,1845,1846,1847,1848,1849,1850,1851,1852,1853,1854,1855,17664,17665,17666,28768,17667,17668,17669,28769,17670,17671,17672,28770,17673,17674,17675,28771,17676,17677,17678,28772,17679,17680,17681,28773,17682,17683,17684,28774,17685,17686,17687,28775,17688,17689,17690,28776,17691,17692,17693,28777,17694,17695,17408,28778,17409,17410,17411,28779,17412,17413,17414,28780,17415,17416,17417,28781,17418,17419,17420,28782,17421,17422,17423,28783,17424,17425,17426,28784,17427,17428,17429,28785,17430,17431,17432,28786,17433,17434,17435,28787,17436,17437,17438,28788,17439,16896,16897,28789,16898,16899,16900,28790,16901,16902,16903,28791,16904,16905,16906,28792,16907,16908,16909,28793,16910,16911,16912,28794,16913,16914,16915,28795,16916,16917,16918,28796,16919,16920,16921,28797,16922,16923,16924,28798,16925,16926,16927,28799,8192,8193,8194,8195,8196,8197,8198,8199,8200,8201,8202,8203,8204,8205,8206,8207,8208,8209,8210,8211,8212,8213,8214,8215,8216,8217,8218,8219,8220,8221,8222,8223,1280,1281,1282,1283,1284,1285,1286,1287,1288,1289,1290,1291,1292,1293,1294,1295,1296,1297,1298,1299,1300,1301,1302,1303,1304,1305,1306,1307,1308,1309,1310,1311,9728,9729,9730,28800,9731,9732,9733,28801,9734,9735,9736,28802,9737,9738,9739,28803,9740,9741,9742,28804,9743,9744,9745,28805,9746,9747,9748,28806,9749,9750,9751,28807,9752,9753,9754,28808,9755,9756,9757,28809,9758,9759,1024,28810,1025,1026,1027,28811,1028,1029,1030,28812,1031,1032,1033,28813,1034,1035,1036,28814,1037,1038,1039,28815,1040,1041,1042,28816,1043,1044,1045,28817,1046,1047,1048,28818,1049,1050,1051,28819,1052,1053,1054,28820,1055,4864,4865,28821,4866,4867,4868,28822,4869,4870,4871,28823,4872,4873,4874,28824,4875,4876,4877,28825,4878,4879,4880,28826,4881,4882,4883,28827,4884,4885,4886,28828,4887,4888,4889,28829,4890,4891,4892,28830,4893,4894,4895,28831,512,513,514,515,516,517,518,519,520,521,522,523,524,525,526,527,528,529,530,531,532,533,534,535,536,537,538,539,540,541,542,543,256,257,258,259,260,261,262,263,264,265,266,267,268,269,270,271,272,273,274,275,276,277,278,279,280,281,282,283,284,285,286,287,12544,12545,12546,12547,12548,12549,12550,12551,12552,12553,12554,12555,12556,12557,12558,12559,12560,12561,12562,12563,12564,12565,12566,12567,12568,12569,12570,12571,12572,12573,12574,12575,1312,1313,1314,1315,1316,1317,1318,1319,1320,1321,1322,1323,1324,1325,1326,1327,1328,1329,1330,1331,1332,1333,1334,1335,1336,1337,1338,1339,1340,1341,1342,1343,9984,9985,9986,28832,9987,9988,9989,28833,9990,9991,9992,28834,9993,9994,9995,28835,9996,9997,9998,28836,9999,10000,10001,28837,10002,10003,10004,28838,10005,10006,10007,28839,10008,10009,10010,28840,10011,10012,10013,28841,10014,10015,1056,28842,1057,1058,1059,28843,1060,1061,1062,28844,1063,1064,1065,28845,1066,1067,1068,28846,1069,1070,1071,28847,1072,1073,1074,28848,1075,1076,1077,28849,1078,1079,1080,28850,1081,1082,1083,28851,1084,1085,1086,28852,1087,8960,8961,28853,8962,8963,8964,28854,8965,8966,8967,28855,8968,8969,8970,28856,8971,8972,8973,28857,8974,8975,8976,28858,8977,8978,8979,28859,8980,8981,8982,28860,8983,8984,8985,28861,8986,8987,8988,28862,8989,8990,8991,28863,544,545,546,547,548,549,550,551,552,553,554,555,556,557,558,559,560,561,562,563,564,565,566,567,568,569,570,571,572,573,574,575,288,289,290,291,292,293,294,295,296,297,298,299,300,301,302,303,304,305,306,307,308,309,310,311,312,313,314,315,316,317,318,319,16640,16641,16642,16643,16644,16645,16646,16647,16648,16649,16650,16651,16652,16653,16654,16655,16656,16657,16658,16659,16660,16661,16662,16663,16664,16665,16666,16667,16668,16669,16670,16671,5376,5377,5378,5379,5380,5381,5382,5383,5384,5385,5386,5387,5388,5389,5390,5391,5392,5393,5394,5395,5396,5397,5398,5399,5400,5401,5402,5403,5404,5405,5406,5407,5888,5889,5890,28864,5891,5892,5893,28865,5894,5895,5896,28866,5897,5898,5899,28867,5900,5901,5902,28868,5903,5904,5905,28869,5906,5907,5908,28870,5909,5910,5911,28871,5912,5913,5914,28872,5915,5916,5917,28873,5918,5919,17920,28874,17921,17922,17923,28875,17924,17925,17926,28876,17927,17928,17929,28877,17930,17931,17932,28878,17933,17934,17935,28879,17936,17937,17938,28880,17939,17940,17941,28881,17942,17943,17944,28882,17945,17946,17947,28883,17948,17949,17950,28884,17951,768,769,28885,770,771,772,28886,773,774,775,28887,776,777,778,28888,779,780,781,28889,782,783,784,28890,785,786,787,28891,788,789,790,28892,791,792,793,28893,794,795,796,28894,797,798,799,28895,13056,13057,13058,13059,13060,13061,13062,13063,13064,13065,13066,13067,13068,13069,13070,13071,13072,13073,13074,13075,13076,13077,13078,13079,13080,13081,13082,13083,13084,13085,13086,13087,4352,4353,4354,4355,4356,4357,4358,4359,4360,4361,4362,4363,4364,4365,4366,4367,4368,4369,4370,4371,4372,4373,4374,4375,4376,4377,4378,4379,4380,4381,4382,4383,12288,12289,12290,12291,12292,12293,12294,12295,12296,12297,12298,12299,12300,12301,12302,12303,12304,12305,12306,12307,12308,12309,12310,12311,12312,12313,12314,12315,12316,12317,12318,12319,5632,5633,5634,5635,5636,5637,5638,5639,5640,5641,5642,5643,5644,5645,5646,5647,5648,5649,5650,5651,5652,5653,5654,5655,5656,5657,5658,5659,5660,5661,5662,5663,9472,9473,9474,28896,9475,9476,9477,28897,9478,9479,9480,28898,9481,9482,9483,28899,9484,9485,9486,28900,9487,9488,9489,28901,9490,9491,9492,28902,9493,9494,9495,28903,9496,9497,9498,28904,9499,9500,9501,28905,9502,9503,18176,28906,18177,18178,18179,28907,18180,18181,18182,28908,18183,18184,18185,28909,18186,18187,18188,28910,18189,18190,18191,28911,18192,18193,18194,28912,18195,18196,18197,28913,18198,18199,18200,28914,18201,18202,18203,28915,18204,18205,18206,28916,18207,800,801,28917,802,803,804,28918,805,806,807,28919,808,809,810,28920,811,812,813,28921,814,815,816,28922,817,818,819,28923,820,821,822,28924,823,824,825,28925,826,827,828,28926,829,830,831,28927,17152,17153,17154,17155,17156,17157,17158,17159,17160,17161,17162,17163,17164,17165,17166,17167,17168,17169,17170,17171,17172,17173,17174,17175,17176,17177,17178,17179,17180,17181,17182,17183,8448,8449,8450,8451,8452,8453,8454,8455,8456,8457,8458,8459,8460,8461,8462,8463,8464,8465,8466,8467,8468,8469,8470,8471,8472,8473,8474,8475,8476,8477,8478,8479,16384,16385,16386,16387,16388,16389,16390,16391,16392,16393,16394,16395,16396,16397,16398,16399,16400,16401,16402,16403,16404,16405,16406,16407,16408,16409,16410,16411,16412,16413,16414,16415};
__device__ const int B_CHUNK[9] = {0,192,384,576,768,1024,1280,1536,1792};
namespace att {
using s16x4  = __attribute__((ext_vector_type(4))) short;
using f32x16 = __attribute__((ext_vector_type(16))) float;
using u32x4  = __attribute__((ext_vector_type(4))) unsigned;
constexpr int HD = 128;
__device__ __forceinline__ const bf16* secp(const bf16* QKV, int sec, int h) { return QKV + (size_t)(sec * 8 + h) * NTOK * HD; }
constexpr int SHM_V = 64 * 128 * 2, SHM_K = 64 * 128 * 2;
constexpr int LDS_WSF = 2 * SHM_V + 2 * SHM_K;
constexpr int ATT_LDS_BYTES = LDS_WSF + 8 * 64 * 4;
constexpr int B_LDS_WSF = 131072 + 4096;
constexpr float LOG2E = 1.4426950408889634f;
#define KSWZ(row, colB) ((row) * 256 + ((colB) ^ (((row) & 7) << 4)))
#define SBAR() __builtin_amdgcn_sched_barrier(0)
__device__ __forceinline__ int crow(int r, int hi) { return (r & 3) + 8 * (r >> 2) + 4 * hi; }
__device__ __forceinline__ unsigned cvtpk(float lo, float hi) { unsigned r; asm volatile("v_cvt_pk_bf16_f32 %0, %1, %2" : "=v"(r) : "v"(lo), "v"(hi)); return r; }
__device__ __forceinline__ int v_st(int k, int c) { const int kk = k;   return ((kk >> 3) * 4 + (c >> 5)) * 512 + ((kk & 7) * 32 + (c & 31)) * 2; }
__device__ __forceinline__ int v_rd_base(int lane) { return ((lane & 3) << 3) | (((lane >> 2) & 3) << 6) | (((lane >> 4) & 1) << 5) | (((lane >> 5) & 1) << 8); }
constexpr int v_rd_off(int d0, int ks, int half) { return d0 * 512 + ks * 4096 + half * 2048; }
template <int OFF> __device__ __forceinline__ s16x4 tr_read(int vb) { s16x4 r; asm volatile("ds_read_b64_tr_b16 %0, %1 offset:%2" : "=&v"(r) : "v"(vb), "i"(OFF) : "memory"); return r; }
template <int D0> __device__ __forceinline__ void pv_one(f32x16& od, int vb, bf16x8 pa0, bf16x8 pa1, bf16x8 pa2, bf16x8 pa3) {
  const s16x4 l0 = tr_read<v_rd_off(D0, 0, 0)>(vb), h0 = tr_read<v_rd_off(D0, 0, 1)>(vb), l1 = tr_read<v_rd_off(D0, 1, 0)>(vb), h1 = tr_read<v_rd_off(D0, 1, 1)>(vb);
  const s16x4 l2 = tr_read<v_rd_off(D0, 2, 0)>(vb), h2 = tr_read<v_rd_off(D0, 2, 1)>(vb), l3 = tr_read<v_rd_off(D0, 3, 0)>(vb), h3 = tr_read<v_rd_off(D0, 3, 1)>(vb);
  asm volatile("s_waitcnt lgkmcnt(0)" ::: "memory"); SBAR();
#define PK(L, H) (bf16x8){L[0], L[1], L[2], L[3], H[0], H[1], H[2], H[3]}
  od = __builtin_amdgcn_mfma_f32_32x32x16_bf16(pa0, PK(l0, h0), od, 0, 0, 0);
  od = __builtin_amdgcn_mfma_f32_32x32x16_bf16(pa1, PK(l1, h1), od, 0, 0, 0);
  od = __builtin_amdgcn_mfma_f32_32x32x16_bf16(pa2, PK(l2, h2), od, 0, 0, 0);
  od = __builtin_amdgcn_mfma_f32_32x32x16_bf16(pa3, PK(l3, h3), od, 0, 0, 0);
#undef PK
}
struct VFrag { s16x4 l0, h0, l1, h1, l2, h2, l3, h3; };
template <int D0> __device__ __forceinline__ void vfrag_read(VFrag& F, int vb) {
  F.l0 = tr_read<v_rd_off(D0, 0, 0)>(vb); F.h0 = tr_read<v_rd_off(D0, 0, 1)>(vb); F.l1 = tr_read<v_rd_off(D0, 1, 0)>(vb); F.h1 = tr_read<v_rd_off(D0, 1, 1)>(vb);
  F.l2 = tr_read<v_rd_off(D0, 2, 0)>(vb); F.h2 = tr_read<v_rd_off(D0, 2, 1)>(vb); F.l3 = tr_read<v_rd_off(D0, 3, 0)>(vb); F.h3 = tr_read<v_rd_off(D0, 3, 1)>(vb);
}
__device__ __forceinline__ void vfrag_mma(f32x16& od, const VFrag& F, bf16x8 pa0, bf16x8 pa1, bf16x8 pa2, bf16x8 pa3) {
#define PK(L, H) (bf16x8){L[0], L[1], L[2], L[3], H[0], H[1], H[2], H[3]}
  od = __builtin_amdgcn_mfma_f32_32x32x16_bf16(pa0, PK(F.l0, F.h0), od, 0, 0, 0); od = __builtin_amdgcn_mfma_f32_32x32x16_bf16(pa1, PK(F.l1, F.h1), od, 0, 0, 0);
  od = __builtin_amdgcn_mfma_f32_32x32x16_bf16(pa2, PK(F.l2, F.h2), od, 0, 0, 0); od = __builtin_amdgcn_mfma_f32_32x32x16_bf16(pa3, PK(F.l3, F.h3), od, 0, 0, 0);
#undef PK
}
__device__ __forceinline__ void pv_d0(f32x16* o, int vb, bf16x8 pa0, bf16x8 pa1, bf16x8 pa2, bf16x8 pa3) {
  VFrag fA, fB;
  SBAR(); vfrag_read<0>(fA, vb); vfrag_read<1>(fB, vb); asm volatile("s_waitcnt lgkmcnt(8)" ::: "memory"); SBAR(); vfrag_mma(o[0], fA, pa0, pa1, pa2, pa3);
  SBAR(); vfrag_read<2>(fA, vb); asm volatile("s_waitcnt lgkmcnt(8)" ::: "memory"); SBAR(); vfrag_mma(o[1], fB, pa0, pa1, pa2, pa3);
  SBAR(); vfrag_read<3>(fB, vb); asm volatile("s_waitcnt lgkmcnt(8)" ::: "memory"); SBAR(); vfrag_mma(o[2], fA, pa0, pa1, pa2, pa3);
  SBAR(); asm volatile("s_waitcnt lgkmcnt(0)" ::: "memory"); SBAR(); vfrag_mma(o[3], fB, pa0, pa1, pa2, pa3);
}
__device__ __forceinline__ void finishSM(f32x16& p0, f32x16& p1, float alpha, float& l_reg, bf16x8& pa0, bf16x8& pa1, bf16x8& pa2, bf16x8& pa3) {
#pragma unroll
  for (int r = 0; r < 16; ++r) p1[r] = __builtin_amdgcn_exp2f(p1[r]);
  float ps = 0;
#pragma unroll
  for (int r = 0; r < 16; ++r) ps += p0[r];
#pragma unroll
  for (int r = 0; r < 16; ++r) ps += p1[r];
  { auto rr = __builtin_amdgcn_permlane32_swap(__float_as_uint(ps), __float_as_uint(ps), false, false); ps = __uint_as_float(rr[0]) + __uint_as_float(rr[1]); }
  l_reg = l_reg * alpha + ps;
#define PK4(P, BASE, OUT) do { u32x4 w = {cvtpk(P[BASE + 0], P[BASE + 1]), cvtpk(P[BASE + 2], P[BASE + 3]), cvtpk(P[BASE + 4], P[BASE + 5]), cvtpk(P[BASE + 6], P[BASE + 7])}; OUT = *reinterpret_cast<bf16x8*>(&w); } while (0)
  PK4(p0, 0, pa0); PK4(p0, 8, pa1); PK4(p1, 0, pa2); PK4(p1, 8, pa3);
#undef PK4
}
template <int ND0> __device__ __forceinline__ void qkt(f32x16& p0, f32x16& p1, const char* Ks, const bf16x8* qr, int cb0, int r32, int hi) {
  p0 = f32x16{}; p1 = f32x16{};
#pragma unroll
  for (int d0 = 0; d0 < ND0; ++d0) { const int cb = cb0 + (d0 * 16 + hi * 8) * 2;
    const bf16x8 b0 = *reinterpret_cast<const bf16x8*>(Ks + KSWZ(r32, cb));
    const bf16x8 b1 = *reinterpret_cast<const bf16x8*>(Ks + KSWZ(32 + r32, cb));
    p0 = __builtin_amdgcn_mfma_f32_32x32x16_bf16(b0, qr[d0], p0, 0, 0, 0);
    p1 = __builtin_amdgcn_mfma_f32_32x32x16_bf16(b1, qr[d0], p1, 0, 0, 0); }
}
__device__ __forceinline__ float half_sum(float v) {
#pragma unroll
  for (int o = 1; o < 32; o <<= 1) v += __shfl_xor(v, o);
  return v;
}

constexpr float THR2 = 8.f * LOG2E;
__device__ __forceinline__ void partialSM_B(f32x16& p0, f32x16& p1, float& m_reg, float& mn, float& alpha, float dlt, float nslope) {
  constexpr float C = 0.125f * LOG2E;
#pragma unroll
  for (int r = 0; r < 16; ++r) { const float kc = (float)((r & 3) + 8 * (r >> 2));
    p0[r] = fmaf(p0[r], C, fabsf(dlt - kc) * nslope); p1[r] = fmaf(p1[r], C, fabsf(dlt - (kc + 32.f)) * nslope); }
  float pmax = p0[0];
#pragma unroll
  for (int r = 1; r < 16; ++r) pmax = fmaxf(pmax, p0[r]);
#pragma unroll
  for (int r = 0; r < 16; ++r) pmax = fmaxf(pmax, p1[r]);
  { auto rr = __builtin_amdgcn_permlane32_swap(__float_as_uint(pmax), __float_as_uint(pmax), false, false); pmax = fmaxf(__uint_as_float(rr[0]), __uint_as_float(rr[1])); }
  if (__builtin_expect(__all(pmax - m_reg <= THR2), 1)) { mn = m_reg; alpha = 1.f; }
  else { mn = fmaxf(m_reg, pmax); alpha = __builtin_amdgcn_exp2f(m_reg - mn); m_reg = mn; }
#pragma unroll
  for (int r = 0; r < 16; ++r) p0[r] = __builtin_amdgcn_exp2f(p0[r] - mn);
#pragma unroll
  for (int r = 0; r < 16; ++r) p1[r] -= mn;
}
__device__ __forceinline__ void partialSM_lin(f32x16& p0, f32x16& p1, float& m_reg, float& mn, float& alpha, float base, float sh) {
  constexpr float C = 0.125f * LOG2E;
  float pm0 = __builtin_fmaxf(__builtin_fmaxf(p0[0], p0[1]), p0[2]), pm1 = __builtin_fmaxf(__builtin_fmaxf(p1[0], p1[1]), p1[2]);
#pragma unroll
  for (int r = 3; r < 15; r += 2) { pm0 = __builtin_fmaxf(__builtin_fmaxf(pm0, p0[r]), p0[r + 1]); pm1 = __builtin_fmaxf(__builtin_fmaxf(pm1, p1[r]), p1[r + 1]); }
  pm0 = __builtin_fmaxf(pm0, p0[15]); pm1 = __builtin_fmaxf(pm1, p1[15]);
  float pmax = fmaxf(pm0, pm1 + sh);
  { auto rr = __builtin_amdgcn_permlane32_swap(__float_as_uint(pmax), __float_as_uint(pmax), false, false); pmax = fmaxf(__uint_as_float(rr[0]), __uint_as_float(rr[1])); }
  const float smax = fmaf(pmax, C, base);
  if (__builtin_expect(__all(smax - m_reg <= THR2), 1)) { mn = m_reg; alpha = 1.f; }
  else { mn = fmaxf(m_reg, smax); alpha = __builtin_amdgcn_exp2f(m_reg - mn); m_reg = mn; }
  const float off0 = base - mn, off1 = fmaf(sh, C, off0);
#pragma unroll
  for (int r = 0; r < 16; ++r) p0[r] = __builtin_amdgcn_exp2f(fmaf(p0[r], C, off0));
#pragma unroll
  for (int r = 0; r < 16; ++r) p1[r] = fmaf(p1[r], C, off1);
}
__device__ __forceinline__ void qkt_b(f32x16& p0, f32x16& p1, const char* Ks, const bf16x8* qr, int cb0, int r32, int hi, bf16x8 kext, bf16x8 qe) {
  bf16x8 b0[4], b1[4];
#pragma unroll
  for (int d0 = 0; d0 < 4; ++d0) { const int cb = cb0 + (d0 * 16 + hi * 8) * 2;
    b0[d0] = *reinterpret_cast<const bf16x8*>(Ks + KSWZ(r32, cb)); b1[d0] = *reinterpret_cast<const bf16x8*>(Ks + KSWZ(32 + r32, cb)); }
  SBAR();
  p0 = __builtin_amdgcn_mfma_f32_32x32x16_bf16(kext, qe, f32x16{}, 0, 0, 0);
  p1 = __builtin_amdgcn_mfma_f32_32x32x16_bf16(kext, qe, f32x16{}, 0, 0, 0);
#pragma unroll
  for (int d0 = 0; d0 < 4; ++d0) {
    p0 = __builtin_amdgcn_mfma_f32_32x32x16_bf16(b0[d0], qr[d0], p0, 0, 0, 0);
    p1 = __builtin_amdgcn_mfma_f32_32x32x16_bf16(b1[d0], qr[d0], p1, 0, 0, 0); }
}
template <int OFF> __device__ __forceinline__ bf16x8 lds_rd128(int addr) { bf16x8 r; asm volatile("ds_read_b128 %0, %1 offset:%2" : "=&v"(r) : "v"(addr), "i"(OFF) : "memory"); return r; }
__device__ __forceinline__ void qkt_frag(f32x16& p0, f32x16& p1, const bf16x8 (&b0)[4], const bf16x8 (&b1)[4], const bf16x8* qr, bf16x8 kext, bf16x8 qe) {
  p0 = __builtin_amdgcn_mfma_f32_32x32x16_bf16(kext, qe, f32x16{}, 0, 0, 0);
  p1 = p0;
  asm volatile("s_waitcnt lgkmcnt(8)" ::: "memory"); SBAR();
#pragma unroll
  for (int d0 = 0; d0 < 4; ++d0) {
    p0 = __builtin_amdgcn_mfma_f32_32x32x16_bf16(b0[d0], qr[d0], p0, 0, 0, 0);
    p1 = __builtin_amdgcn_mfma_f32_32x32x16_bf16(b1[d0], qr[d0], p1, 0, 0, 0); }
}
constexpr float THETA = 40.f;
__device__ __forceinline__ float bfx(short v) { return __uint_as_float(((unsigned)(unsigned short)v) << 16); }
__device__ __forceinline__ void attn_b_unit(const bf16* __restrict__ QKV, bf16* __restrict__ Y, int base, int S, int h, int q0, float lam, const float* __restrict__ subg, float outscale, const float* __restrict__ kn2p, char* lds) {
  int tid_ = threadIdx.x; asm volatile("" : "+v"(tid_));
  const int tid = tid_, wid = __builtin_amdgcn_readfirstlane(tid >> 6), lane = tid & 63, r32 = lane & 31, hi = lane >> 5, cmap = wid >> 2, wq = wid & 3;
  char* V_lds = lds; char* K_lds = lds + 4 * SHM_V;
  float* ws = (float*)(lds + B_LDS_WSF) + wid * 64; float* li_l = ws; float* al_l = ws + 32;
  float m_reg = -1e30f, l_reg = 0; f32x16 o[4] = {}; bf16x8 qr[4];
  const int qi = q0 + wq * 32 + r32;
  const bf16* Qw = secp(QKV, 3, h) + (size_t)(base + qi) * HD + cmap * 64 + hi * 8;
#pragma unroll
  for (int d0 = 0; d0 < 4; ++d0) qr[d0] = *reinterpret_cast<const bf16x8*>(Qw + d0 * 16);
  const bf16* Kh = secp(QKV, 4, h) + (size_t)base * HD; const bf16* Vh = secp(QKV, 5, h) + (size_t)base * HD;
  const int sr = tid >> 4, sc = (tid & 15) * 8, vst0 = v_st(sr, sc), vst1 = v_st(32 + sr, sc);
  const int vb0 = (int)(uintptr_t)V_lds + v_rd_base(lane);
  const int cb0 = cmap * 128;
  const float nslope = __uint_as_float(__builtin_amdgcn_readfirstlane(__float_as_uint(-LOG2E * __builtin_amdgcn_exp2f(-(float)(h + 1)))));
  int t_lo, NT;
  { float qn2 = 0.f, sdot = 0.f;
    const bf16* Kself = secp(QKV, 4, h) + (size_t)(base + qi) * HD + cmap * 64 + hi * 8;
    bf16x8 kvs[4];
#pragma unroll
    for (int d0 = 0; d0 < 4; ++d0) kvs[d0] = *reinterpret_cast<const bf16x8*>(Kself + d0 * 16);
    asm volatile("" : "+v"(kvs[0]), "+v"(kvs[1]), "+v"(kvs[2]), "+v"(kvs[3]));
#pragma unroll
    for (int d0 = 0; d0 < 4; ++d0) {
#pragma unroll
      for (int e = 0; e < 8; ++e) { const float qf = bfx(qr[d0][e]), kf = bfx(kvs[d0][e]); qn2 = fmaf(qf, qf, qn2); sdot = fmaf(qf, kf, sdot); } }
    qn2 += __shfl_xor(qn2, 32); sdot += __shfl_xor(sdot, 32);
    constexpr float C = 0.125f * LOG2E;
    float Ri = (C * sqrtf(qn2 * kn2p[cmap]) * 1.001f - C * sdot + THETA) / (-nslope);
#pragma unroll
    for (int o_ = 1; o_ < 32; o_ <<= 1) Ri = fmaxf(Ri, __shfl_xor(Ri, o_));
    float* rbuf = (float*)(lds + B_LDS_WSF + 8 * 64 * 4);
    if (lane == 0) rbuf[wid] = Ri;
    __syncthreads();
    float R = rbuf[0];
#pragma unroll
    for (int w_ = 1; w_ < 8; ++w_) R = fmaxf(R, rbuf[w_]);
    const int Rint = (int)fminf(fmaxf(R, 0.f), 1.0e6f) + 1, NTall = S / 64;
    int lo_ = q0 - Rint; lo_ = lo_ < 0 ? 0 : lo_; t_lo = lo_ >> 6;
    int t_hi = (q0 + 127 + Rint) >> 6; t_hi = t_hi > NTall - 1 ? NTall - 1 : t_hi;
    if (((t_hi - t_lo + 1) & 1) != 0) { if (t_hi < NTall - 1) ++t_hi; else --t_lo; }
    NT = t_hi - t_lo + 1;
    t_lo = __builtin_amdgcn_readfirstlane(t_lo); NT = __builtin_amdgcn_readfirstlane(NT);
  }
  const int kbase = t_lo * 64;
  const float di0 = (float)(qi - kbase);
  const int tdr = ((q0 + wq * 32) >> 6) - t_lo;
  const float s8 = __uint_as_float(__builtin_amdgcn_readfirstlane(__float_as_uint(__builtin_amdgcn_exp2f((float)(2 - h)))));
  const unsigned s8b = hi == 0 ? (__float_as_uint(s8) >> 16) : 0u;
  bf16x8 kext = {0, 0, 0, 0, 0, 0, 0, 0};
  if (hi == 0) kext[0] = (short)(__float_as_uint((float)r32) >> 16);
#define QKT(P0, P1, KS, idx) do { v4u qe_ = {s8b ^ (((idx) > tdr) ? 0x8000u : 0u), 0u, 0u, 0u}; qkt_b(P0, P1, KS, qr, cb0, r32, hi, kext, __builtin_bit_cast(bf16x8, qe_)); } while (0)
  int kofs[4];
#pragma unroll
  for (int d0 = 0; d0 < 4; ++d0) kofs[d0] = (int)(uintptr_t)K_lds + KSWZ(r32, cb0 + (d0 * 16 + hi * 8) * 2);
#define QKTF(P0, P1, B0, B1, idx) do { v4u qe_ = {s8b ^ (((idx) > tdr) ? 0x8000u : 0u), 0u, 0u, 0u}; qkt_frag(P0, P1, B0, B1, qr, kext, __builtin_bit_cast(bf16x8, qe_)); } while (0)
#define PSM(P0, P1, MN, AL, idx) do { const float dd_ = di0 - (float)((idx) * 64); \
    if ((idx) == tdr) { const float c2_ = -2.f * s8, dk_ = dd_ - (float)(4 * hi); \
      _Pragma("unroll") for (int r = 0; r < 16; ++r) { const float kc_ = (float)((r & 3) + 8 * (r >> 2)); P0[r] = fmaf(fmaxf(kc_ - dk_, 0.f), c2_, P0[r]); P1[r] = fmaf(fmaxf(kc_ + 32.f - dk_, 0.f), c2_, P1[r]); } } \
    partialSM_lin(P0, P1, m_reg, MN, AL, nslope * fabsf(dd_), ((idx) > tdr) ? -32.f * s8 : 32.f * s8); } while (0)
  const int wq4 = wid & 3;
  unsigned koff[2], voff[2];
#pragma unroll
  for (int i_ = 0; i_ < 2; ++i_) { const int b_ = 8192 * cmap + (wq4 * 2 + i_) * 1024 + lane * 16;
    const int row_ = b_ >> 8, pos_ = (b_ >> 4) & 15; koff[i_] = (unsigned)(row_ * 256 + ((pos_ ^ (row_ & 7)) << 4));
    const int sub_ = b_ >> 9, e_ = (b_ & 511) >> 1, kk_ = (sub_ >> 2) * 8 + (e_ >> 5), k_ = kk_;
    voff[i_] = (unsigned)(k_ * 256 + ((sub_ & 3) * 32 + (e_ & 31)) * 2); }
  const unsigned ldsK = (unsigned)(uintptr_t)K_lds + 8192u * cmap + 2048u * wq4, ldsV = (unsigned)(uintptr_t)V_lds + 8192u * cmap + 2048u * wq4;
#define SLOT(t) (((t) & 3) * SHM_V)
#define DMA_TILE(t) do { const char* kt_ = (const char*)Kh + (size_t)(kbase + (t) * 64) * 256; const char* vt_ = (const char*)Vh + (size_t)(kbase + (t) * 64) * 256; const unsigned so_ = SLOT(t); \
    _Pragma("unroll") for (int i_ = 0; i_ < 2; ++i_) { \
      __builtin_amdgcn_global_load_lds((const unsigned*)(kt_ + koff[i_]), (LAS unsigned*)(ldsK + so_ + i_ * 1024), 16, 0, 0); \
      __builtin_amdgcn_global_load_lds((const unsigned*)(vt_ + voff[i_]), (LAS unsigned*)(ldsV + so_ + i_ * 1024), 16, 0, 0); } } while (0)
#define RESC(a) do { if (__any((a) < 1.f)) { if (hi == 0) al_l[r32] = (a); asm volatile("s_waitcnt lgkmcnt(0)" ::: "memory"); \
    _Pragma("unroll") for (int d = 0; d < 4; ++d) _Pragma("unroll") for (int r = 0; r < 16; ++r) o[d][r] *= al_l[crow(r, hi)]; } } while (0)
#define BARM() do { SBAR(); asm volatile("s_waitcnt lgkmcnt(0)\n\ts_barrier" ::: "memory"); SBAR(); } while (0)
#define BARL(t) do { SBAR(); if ((t) < NT) asm volatile("s_waitcnt vmcnt(4) lgkmcnt(0)\n\ts_barrier" ::: "memory"); else asm volatile("s_waitcnt vmcnt(0) lgkmcnt(0)\n\ts_barrier" ::: "memory"); SBAR(); } while (0)
  struct VF { s16x4 l0, h0, l1, h1, l2, h2, l3, h3; };
#define TR8(F, VB, D0) do { F.l0 = tr_read<v_rd_off(D0, 0, 0)>(VB); F.h0 = tr_read<v_rd_off(D0, 0, 1)>(VB); F.l1 = tr_read<v_rd_off(D0, 1, 0)>(VB); F.h1 = tr_read<v_rd_off(D0, 1, 1)>(VB); \
    F.l2 = tr_read<v_rd_off(D0, 2, 0)>(VB); F.h2 = tr_read<v_rd_off(D0, 2, 1)>(VB); F.l3 = tr_read<v_rd_off(D0, 3, 0)>(VB); F.h3 = tr_read<v_rd_off(D0, 3, 1)>(VB); } while (0)
#define PKF(L, H) (bf16x8){L[0], L[1], L[2], L[3], H[0], H[1], H[2], H[3]}
#define MF4(OD, F) do { OD = __builtin_amdgcn_mfma_f32_32x32x16_bf16(pa0, PKF(F.l0, F.h0), OD, 0, 0, 0); OD = __builtin_amdgcn_mfma_f32_32x32x16_bf16(pa1, PKF(F.l1, F.h1), OD, 0, 0, 0); \
    OD = __builtin_amdgcn_mfma_f32_32x32x16_bf16(pa2, PKF(F.l2, F.h2), OD, 0, 0, 0); OD = __builtin_amdgcn_mfma_f32_32x32x16_bf16(pa3, PKF(F.l3, F.h3), OD, 0, 0, 0); } while (0)
#define WAITL(n) asm volatile("s_waitcnt lgkmcnt(" #n ")" ::: "memory")
#define MSEG(jj) do { const int vbp_ = vb0 + SLOT((jj) - 1), ks_ = SLOT(jj); VF fA_, fB_, fC_; bf16x8 kb0_[4], kb1_[4]; \
    SBAR(); _Pragma("unroll") for (int d0 = 0; d0 < 4; ++d0) { kb0_[d0] = lds_rd128<0>(kofs[d0] + ks_); kb1_[d0] = lds_rd128<8192>(kofs[d0] + ks_); } \
    TR8(fA_, vbp_, 0); SBAR(); QKTF(pC0, pC1, kb0_, kb1_, jj);   \
    SBAR(); TR8(fB_, vbp_, 1); WAITL(8); SBAR(); MF4(o[0], fA_); \
    SBAR(); TR8(fC_, vbp_, 2); WAITL(8); SBAR(); MF4(o[1], fB_); \
    SBAR(); TR8(fA_, vbp_, 3); WAITL(8); SBAR(); MF4(o[2], fC_); \
    SBAR(); WAITL(0); SBAR(); MF4(o[3], fA_); } while (0)
#define LSEG(jj) do { PSM(pC0, pC1, mnC, alC, jj); finishSM(pC0, pC1, alC, l_reg, pa0, pa1, pa2, pa3); RESC(alC); \
    const int tn_ = (jj) + 2 + cmap; if (tn_ < NT) DMA_TILE(tn_); BARL(tn_); } while (0)
  f32x16 pC0, pC1; float mnC = 0.f, alC = 1.f; bf16x8 pa0, pa1, pa2, pa3;
  DMA_TILE(0); DMA_TILE(1); if (cmap == 1 && 2 < NT) DMA_TILE(2);
  SBAR(); if (cmap == 1 && 2 < NT) asm volatile("s_waitcnt vmcnt(4) lgkmcnt(0)\n\ts_barrier" ::: "memory"); else asm volatile("s_waitcnt vmcnt(0) lgkmcnt(0)\n\ts_barrier" ::: "memory"); SBAR();
  if (cmap == 1) BARM();
  SBAR(); QKT(pC0, pC1, K_lds, 0); BARM(); LSEG(0);
  if (cmap == 1) __builtin_amdgcn_s_setprio(1);
  for (int j = 1; j < NT; ++j) { MSEG(j); BARM(); LSEG(j); }
  __builtin_amdgcn_s_setprio(0);
  { const int vbp_ = vb0 + SLOT(NT - 1); VF fA_, fB_, fC_;
    SBAR(); TR8(fA_, vbp_, 0); TR8(fB_, vbp_, 1); TR8(fC_, vbp_, 2); WAITL(8); SBAR(); MF4(o[0], fA_); MF4(o[1], fB_);
    SBAR(); TR8(fA_, vbp_, 3); WAITL(8); SBAR(); MF4(o[2], fC_);
    SBAR(); WAITL(0); SBAR(); MF4(o[3], fA_); }
  if (cmap == 0) BARM();
#undef SLOT
#undef DMA_TILE
#undef BARM
#undef BARL
#undef TR8
#undef PKF
#undef MF4
#undef WAITL
#undef MSEG
#undef LSEG
  if (hi == 0) li_l[r32] = l_reg; asm volatile("s_waitcnt lgkmcnt(0)" ::: "memory");
  float rli[16];
#pragma unroll
  for (int r = 0; r < 16; ++r) rli[r] = __builtin_amdgcn_rcpf(li_l[crow(r, hi)]);
  __syncthreads();
  float* X = (float*)lds + wq * (32 * 128);
  if (cmap == 1) {
#pragma unroll
    for (int r = 0; r < 16; ++r)
#pragma unroll
      for (int d0 = 0; d0 < 4; ++d0) X[crow(r, hi) * 128 + d0 * 32 + r32] = o[d0][r] * (rli[r] * lam);
  }
  __syncthreads();
  if (cmap == 0) {
    float gv[4];
#pragma unroll
    for (int d0 = 0; d0 < 4; ++d0) gv[d0] = subg[d0 * 32 + r32] * outscale;
#pragma unroll
    for (int r = 0; r < 16; ++r) { float ss = 0.f;
#pragma unroll
      for (int d0 = 0; d0 < 4; ++d0) { const float v = o[d0][r] * rli[r] - X[crow(r, hi) * 128 + d0 * 32 + r32]; o[d0][r] = v; ss += v * v; }
      ss = half_sum(ss);
      const float rstd = 1.0f / sqrtf(ss * (1.f / 128.f) + 1e-6f);
#pragma unroll
      for (int d0 = 0; d0 < 4; ++d0) o[d0][r] *= rstd * gv[d0]; }
    asm volatile("s_waitcnt lgkmcnt(0)" ::: "memory");
    bf16* stg = (bf16*)X;
#pragma unroll
    for (int r = 0; r < 16; ++r)
#pragma unroll
      for (int d0 = 0; d0 < 4; ++d0) stg[crow(r, hi) * 128 + d0 * 32 + r32] = (bf16)(pg8::cvt_pk_op(o[d0][r], 0.f) & 0xffffu);
    asm volatile("s_waitcnt lgkmcnt(0)" ::: "memory");
    bf16* Yw = Y + (size_t)(base + q0 + wq * 32) * 2048 + 1024 + h * 128;
#pragma unroll
    for (int i = 0; i < 8; ++i) { const int row = i * 4 + (lane >> 4), ch = lane & 15; const u32x4 v = *(const u32x4*)(stg + row * 128 + ch * 8); *(u32x4*)(Yw + (size_t)row * 2048 + ch * 8) = v; }
  }
  __syncthreads();
#undef QKT
#undef QKTF
#undef PSM
#undef RESC
}

struct AStage { bf16x8 vs0, vs1, ks0, ks1; };
struct ANext { bool has; const bf16* Kh; const bf16* Vh; const bf16* Qh; size_t rstride; int a, L; };
__device__ __forceinline__ void attn_a_unit(const bf16* __restrict__ QKV, bf16* __restrict__ OA, float* __restrict__ LSE, int base, int L, int dil, int rho, int a, int h, char* lds, AStage& st0, AStage& st1, bf16x8 (&qr)[8], bool pre, const ANext nx) {
  int tid_ = threadIdx.x; asm volatile("" : "+v"(tid_));
  const int tid = tid_, wid = __builtin_amdgcn_readfirstlane(tid >> 6), lane = tid & 63, r32 = lane & 31, hi = lane >> 5;
  char* V_lds = lds; char* K_lds = lds + 2 * SHM_V;
  float* ws = (float*)(lds + LDS_WSF) + wid * 64; float* li_l = ws; float* al_l = ws + 32;
  float m_reg = -1e30f, l_reg = 0; f32x16 o[4] = {};
  const int qs = a + wid * 32 + r32;
  const bf16* Qw = secp(QKV, 0, h) + (size_t)(base + rho + dil * qs) * HD + hi * 8;
#pragma unroll
  for (int d0 = 0; d0 < 8; ++d0) if (!pre) qr[d0] = *reinterpret_cast<const bf16x8*>(Qw + d0 * 16);
  const bf16* Kh = secp(QKV, 1, h) + (size_t)(base + rho) * HD; const bf16* Vh = secp(QKV, 2, h) + (size_t)(base + rho) * HD;
  const int sr = tid >> 4, sc = (tid & 15) * 8, vst0 = v_st(sr, sc), vst1 = v_st(32 + sr, sc);
  const int vb0 = (int)(uintptr_t)V_lds + v_rd_base(lane);
  constexpr float C = 0.08838834764831845f * LOG2E;
  const float nslope = -LOG2E * (float)dil * __builtin_amdgcn_exp2f(-0.5f * (float)(2 * h + 1));
  const size_t rstride = (size_t)dil * HD;
#define SLOADX(st, t, Kh_, Vh_, rs_, a_, L_) do { int k0_ = (a_) - 64 + 64 * (t) + sr, k1_ = k0_ + 32; k0_ = k0_ < 0 ? 0 : (k0_ >= (L_) ? (L_) - 1 : k0_); k1_ = k1_ < 0 ? 0 : (k1_ >= (L_) ? (L_) - 1 : k1_); \
    st.vs0 = *(const bf16x8*)(&(Vh_)[(size_t)k0_ * (rs_) + sc]); st.vs1 = *(const bf16x8*)(&(Vh_)[(size_t)k1_ * (rs_) + sc]); \
    st.ks0 = *(const bf16x8*)(&(Kh_)[(size_t)k0_ * (rs_) + sc]); st.ks1 = *(const bf16x8*)(&(Kh_)[(size_t)k1_ * (rs_) + sc]); } while (0)
#define SLOADA(st, t) SLOADX(st, t, Kh, Vh, rstride, a, L)
#define SWRITEA(st, b) do { *(bf16x8*)(V_lds + (b) * SHM_V + vst0) = st.vs0; *(bf16x8*)(V_lds + (b) * SHM_V + vst1) = st.vs1; const int kc_ = sc * 2; \
    *(bf16x8*)(K_lds + (b) * SHM_K + KSWZ(sr, kc_)) = st.ks0; *(bf16x8*)(K_lds + (b) * SHM_K + KSWZ(32 + sr, kc_)) = st.ks1; } while (0)
  if (!pre) { SLOADA(st0, 0); SLOADA(st1, 1); asm volatile("s_waitcnt vmcnt(4)" ::: "memory"); }
  SWRITEA(st0, 0); __syncthreads();
  const int t_lo = wid >> 1;
#define A_COMPUTE(t, b) do { \
    if ((t) >= t_lo && (t) <= t_lo + 2) { \
      f32x16 p0, p1; \
      qkt<8>(p0, p1, K_lds + (b) * SHM_K, qr, 0, r32, hi); \
      const int kb = a - 64 + 64 * (t) + 4 * hi; \
      const float dlt = (float)(qs - kb); \
      _Pragma("unroll") \
      for (int r = 0; r < 16; ++r) { const int kci = (r & 3) + 8 * (r >> 2); const float kc = (float)kci; \
        const float u0 = fabsf(dlt - kc), u1 = fabsf(dlt - (kc + 32.f)); \
        const bool ok0 = (u0 <= 64.f) && ((unsigned)(kb + kci) < (unsigned)L), ok1 = (u1 <= 64.f) && ((unsigned)(kb + kci + 32) < (unsigned)L); \
        p0[r] = ok0 ? fmaf(p0[r], C, u0 * nslope) : -INFINITY; p1[r] = ok1 ? fmaf(p1[r], C, u1 * nslope) : -INFINITY; } \
      float pmax = p0[0]; \
      _Pragma("unroll") \
      for (int r = 1; r < 16; ++r) pmax = fmaxf(pmax, p0[r]); \
      _Pragma("unroll") \
      for (int r = 0; r < 16; ++r) pmax = fmaxf(pmax, p1[r]); \
      { auto rr = __builtin_amdgcn_permlane32_swap(__float_as_uint(pmax), __float_as_uint(pmax), false, false); pmax = fmaxf(__uint_as_float(rr[0]), __uint_as_float(rr[1])); } \
      const float mn = fmaxf(m_reg, pmax), alpha = __builtin_amdgcn_exp2f(m_reg - mn); m_reg = mn; \
      _Pragma("unroll") \
      for (int r = 0; r < 16; ++r) { p0[r] = __builtin_amdgcn_exp2f(p0[r] - mn); p1[r] -= mn; } \
      bf16x8 pa0, pa1, pa2, pa3; \
      finishSM(p0, p1, alpha, l_reg, pa0, pa1, pa2, pa3); \
      if (__any(alpha < 1.f)) { if (hi == 0) al_l[r32] = alpha; asm volatile("s_waitcnt lgkmcnt(0)" ::: "memory"); \
      _Pragma("unroll") \
        for (int d = 0; d < 4; ++d) \
      _Pragma("unroll") \
          for (int r = 0; r < 16; ++r) o[d][r] *= al_l[crow(r, hi)]; } \
      SBAR(); \
      pv_d0(o, vb0 + (b) * SHM_V, pa0, pa1, pa2, pa3); \
    } \
  } while (0)
  asm volatile("" : "+v"(qr[0]), "+v"(qr[1]), "+v"(qr[2]), "+v"(qr[3]), "+v"(qr[4]), "+v"(qr[5]), "+v"(qr[6]), "+v"(qr[7]));
#pragma unroll
  for (int t = 0; t < 6; t += 2) {
    if (t + 2 < 6) SLOADA(st0, t + 2); else SLOADX(st0, 0, nx.Kh, nx.Vh, nx.rstride, nx.a, nx.L);
    A_COMPUTE(t, 0);
    asm volatile("s_waitcnt vmcnt(4)" ::: "memory");
    SWRITEA(st1, 1);
    __syncthreads();
    if (t + 3 < 6) SLOADA(st1, t + 3); else SLOADX(st1, 1, nx.Kh, nx.Vh, nx.rstride, nx.a, nx.L);
    A_COMPUTE(t + 1, 1);
    if (t + 2 < 6) { if (t + 3 < 6) asm volatile("s_waitcnt vmcnt(4)" ::: "memory"); else asm volatile("s_waitcnt vmcnt(0)" ::: "memory"); SWRITEA(st0, 0); }
    __syncthreads();
  }
#undef A_COMPUTE
  { const bf16* Qn = nx.Qh + (size_t)(nx.a + wid * 32 + r32) * nx.rstride + hi * 8;
#pragma unroll
    for (int d0 = 0; d0 < 8; ++d0) qr[d0] = *reinterpret_cast<const bf16x8*>(Qn + d0 * 16); }
  if (hi == 0) li_l[r32] = l_reg; asm volatile("s_waitcnt lgkmcnt(0)" ::: "memory");
  float rli[16];
#pragma unroll
  for (int r = 0; r < 16; ++r) rli[r] = __builtin_amdgcn_rcpf(li_l[crow(r, hi)]);
  bf16* stg = (bf16*)lds + wid * (32 * 128);
#pragma unroll
  for (int r = 0; r < 16; ++r)
#pragma unroll
    for (int d0 = 0; d0 < 4; ++d0) stg[crow(r, hi) * 128 + d0 * 32 + r32] = (bf16)(cvtpk(o[d0][r] * rli[r], 0.f) & 0xffffu);
  asm volatile("s_waitcnt lgkmcnt(0)" ::: "memory");
  const size_t tok0 = (size_t)base + rho + (size_t)dil * (a + wid * 32);
#pragma unroll
  for (int i = 0; i < 8; ++i) { const int row = i * 4 + (lane >> 4), ch = lane & 15; const u32x4 v = *(const u32x4*)(stg + row * 128 + ch * 8);
    *(u32x4*)(OA + (tok0 + (size_t)dil * row) * 1024 + h * 128 + ch * 8) = v; }
  if (hi == 0) LSE[(tok0 + (size_t)dil * r32) * 8 + h] = m_reg + __builtin_amdgcn_logf(l_reg);
  __syncthreads();
#undef SLOADA
#undef SLOADX
#undef SWRITEA
}
struct MergeLoads { float l0, l1, l2; u32x4 v[3][2]; };
__device__ __forceinline__ void attn_a_merge_load(MergeLoads& M, const bf16* __restrict__ OA, const float* __restrict__ LSE, int tok, int lane) {
  const int h = lane >> 3, dseg = (lane & 7) * 16;
  M.l0 = LSE[(size_t)tok * 8 + h]; M.l1 = LSE[((size_t)NTOK + tok) * 8 + h]; M.l2 = LSE[((size_t)2 * NTOK + tok) * 8 + h];
#pragma unroll
  for (int b = 0; b < 3; ++b) { const u32x4* p = (const u32x4*)(OA + ((size_t)b * NTOK + tok) * 1024 + h * 128 + dseg); M.v[b][0] = p[0]; M.v[b][1] = p[1]; }
}
__device__ __forceinline__ void attn_a_merge_finish(const MergeLoads& M, bf16* __restrict__ Y, const f32x4 (&gq)[4], int tok, int lane) {
  const int h = lane >> 3, dseg = (lane & 7) * 16;
  float w[3]; { const float mx = fmaxf(M.l0, fmaxf(M.l1, M.l2)); w[0] = __builtin_amdgcn_exp2f(M.l0 - mx); w[1] = __builtin_amdgcn_exp2f(M.l1 - mx); w[2] = __builtin_amdgcn_exp2f(M.l2 - mx);
    const float rs = 1.f / (w[0] + w[1] + w[2]); w[0] *= rs; w[1] *= rs; w[2] *= rs; }
  float acc[16];
#pragma unroll
  for (int e = 0; e < 16; ++e) acc[e] = 0.f;
#pragma unroll
  for (int b = 0; b < 3; ++b) { const u32x4 v0 = M.v[b][0], v1 = M.v[b][1];
#pragma unroll
    for (int e = 0; e < 4; ++e) { acc[2 * e] += w[b] * __uint_as_float(v0[e] << 16); acc[2 * e + 1] += w[b] * __uint_as_float(v0[e] & 0xffff0000u);
                                  acc[8 + 2 * e] += w[b] * __uint_as_float(v1[e] << 16); acc[8 + 2 * e + 1] += w[b] * __uint_as_float(v1[e] & 0xffff0000u); } }
  float ss = 0.f;
#pragma unroll
  for (int e = 0; e < 16; ++e) ss += acc[e] * acc[e];
  ss += __shfl_xor(ss, 1); ss += __shfl_xor(ss, 2); ss += __shfl_xor(ss, 4);
  const float rstd = 1.0f / sqrtf(ss * (1.f / 128.f) + 1e-6f);
  u32x4 o0, o1;
#pragma unroll
  for (int e = 0; e < 4; ++e) { o0[e] = pg8::cvt_pk_op(acc[2 * e] * rstd * gq[(2 * e) >> 2][(2 * e) & 3], acc[2 * e + 1] * rstd * gq[(2 * e + 1) >> 2][(2 * e + 1) & 3]);
                                o1[e] = pg8::cvt_pk_op(acc[8 + 2 * e] * rstd * gq[(8 + 2 * e) >> 2][(8 + 2 * e) & 3], acc[8 + 2 * e + 1] * rstd * gq[(9 + 2 * e) >> 2][(9 + 2 * e) & 3]); }
  u32x4* yo = (u32x4*)(Y + (size_t)tok * 2048 + h * 128 + dseg); yo[0] = o0; yo[1] = o1;
}
__device__ __forceinline__ void attn_a_merge_row(const bf16* __restrict__ OA, const float* __restrict__ LSE, bf16* __restrict__ Y, const float* __restrict__ g, int tok, int lane) {
  f32x4 gq[4]; for (int k = 0; k < 4; ++k) gq[k] = *(const f32x4*)(g + (lane & 7) * 16 + 4 * k);
  MergeLoads M; attn_a_merge_load(M, OA, LSE, tok, lane); attn_a_merge_finish(M, Y, gq, tok, lane);
}
#undef KSWZ
#undef SBAR
}
__device__ __forceinline__ void p0_item(const float* W, int K, int N, bf16* WT, int mode, const float* g, const float* b, pg8::vec_t* cs, pg8::vec_t* bw, LAS unsigned* stg, int item, int lane) {
    const int nblk = N / 64, kgi = item / nblk, nb = item % nblk, n0 = 64 * nb;
    const int r0 = mode == 0 ? n0 : ((n0 >> 7) * 256 + (n0 & 127) + (mode == 2 ? 128 : 0));
    const int kq = lane & 3, nq = lane >> 2;
    f32x4 acs = {0.f, 0.f, 0.f, 0.f}, abw = {0.f, 0.f, 0.f, 0.f};
    for (int kb = kgi * 4; kb < kgi * 4 + 4; ++kb) {
        const int k0 = 64 * kb + 16 * kq;
        const GAS float* wp = (const GAS float*)W + (size_t)k0 * N + n0 + 4 * nq;
        f32x4 v[16];
#pragma unroll
        for (int j = 0; j < 16; ++j) v[j] = *(const GAS f32x4*)(wp + (size_t)j * N);
        unsigned pk[4][8];
        if (g) {
            f32x4 gq[4], bq[4];
#pragma unroll
            for (int t = 0; t < 4; ++t) { gq[t] = *(const GAS f32x4*)(g + k0 + 4 * t); bq[t] = *(const GAS f32x4*)(b + k0 + 4 * t); }
#pragma unroll
            for (int p = 0; p < 8; ++p) { const float g0 = gq[(2 * p) >> 2][(2 * p) & 3], g1 = gq[(2 * p + 1) >> 2][(2 * p + 1) & 3], b0 = bq[(2 * p) >> 2][(2 * p) & 3], b1 = bq[(2 * p + 1) >> 2][(2 * p + 1) & 3];
#pragma unroll
                for (int e = 0; e < 4; ++e) { const float w0 = v[2 * p][e], w1 = v[2 * p + 1][e]; const unsigned q = pg8::cvt_pk_op(w0 * g0, w1 * g1); pk[e][p] = q;
                    acs[e] += pg8::op_lo(q) + pg8::op_hi(q); abw[e] = fmaf(b0, w0, fmaf(b1, w1, abw[e])); } }
        } else {
#pragma unroll
            for (int p = 0; p < 8; ++p)
#pragma unroll
                for (int e = 0; e < 4; ++e) pk[e][p] = pg8::cvt_pk_op(v[2 * p][e], v[2 * p + 1][e]);
        }
#pragma unroll
        for (int e = 0; e < 4; ++e) { LAS v4u* rowp = (LAS v4u*)(stg + (4 * nq + e) * 36 + 8 * kq);
            rowp[0] = (v4u){pk[e][0], pk[e][1], pk[e][2], pk[e][3]}; rowp[1] = (v4u){pk[e][4], pk[e][5], pk[e][6], pk[e][7]}; }
        LDS_WAIT(); asm volatile("" ::: "memory");
#pragma unroll
        for (int i = 0; i < 8; ++i) { const int row = i * 8 + (lane >> 3), c = lane & 7; const v4u o = *(const LAS v4u*)(stg + row * 36 + 4 * c);
            *(GAS v4u*)(WT + (size_t)(r0 + row) * K + 64 * kb + 8 * c) = o; }
        LDS_WAIT(); asm volatile("" ::: "memory");
    }
    if (g) {
#pragma unroll
        for (int e = 0; e < 4; ++e) { acs[e] += __shfl_xor(acs[e], 1); acs[e] += __shfl_xor(acs[e], 2); abw[e] += __shfl_xor(abw[e], 1); abw[e] += __shfl_xor(abw[e], 2); }
        if (kq == 0) {
#pragma unroll
            for (int e = 0; e < 4; ++e) { __hip_atomic_fetch_add(cs + r0 + 4 * nq + e, (int)__builtin_rintf(acs[e] * pg8::VEC_SCALE), __ATOMIC_RELAXED, __HIP_MEMORY_SCOPE_AGENT); __hip_atomic_fetch_add(bw + r0 + 4 * nq + e, (int)__builtin_rintf(abw[e] * pg8::VEC_SCALE), __ATOMIC_RELAXED, __HIP_MEMORY_SCOPE_AGENT); } }
    }
}
struct Args { const float* in[NIN]; float* out; unsigned char* ws; int ph_lo, ph_hi; };

constexpr int CV_I_GU = (DFF / 64) * (DM / 256), CV_I_D = (DM / 64) * (DFF / 256), CV_I_IN = (INW / 64) * (DM / 256), CV_I_OUT = (DM / 64) * (DM / 256);
constexpr int CV_I_LAYER = 4 * CV_I_GU + 2 * CV_I_D + CV_I_IN + CV_I_OUT;
#ifndef MK_CV_TAIL_LO
#define MK_CV_TAIL_LO 0
#endif
constexpr int CV_TAIL_LO = MK_CV_TAIL_LO;
__device__ __forceinline__ void convert_layer_items(Frame& F, const Args& a, int l, int lo, int hi, int widx, int nw) {
    LAS unsigned* scr = (LAS unsigned*)(F.lds + RING_OFF + F.wave * 16384);
    unsigned char* wl = a.ws + WS_W + (size_t)l * SZ_LAYER;
    pg8::vec_t* vec = (pg8::vec_t*)(a.ws + WS_VEC) + (size_t)l * V_LAYER;
    const float* g1 = l ? a.in[20] + (l - 1) * DM : nullptr; const float* b1 = l ? a.in[21] + (l - 1) * DM : nullptr;
    for (int it = lo + widx; it < hi; it += nw) {
        int r = it;
        if (r < CV_I_GU) { p0_item(a.in[4] + (size_t)l * DM * DFF, DM, DFF, (bf16*)(wl + OFF_W1A), 1, g1, b1, vec + V_CS1, vec + V_BW1, scr, r, flane()); continue; } r -= CV_I_GU;
        if (r < CV_I_GU) { p0_item(a.in[5] + (size_t)l * DM * DFF, DM, DFF, (bf16*)(wl + OFF_W1A), 2, g1, b1, vec + V_CS1, vec + V_BW1, scr, r, flane()); continue; } r -= CV_I_GU;
        if (r < CV_I_D)  { p0_item(a.in[6] + (size_t)l * DFF * DM, DFF, DM, (bf16*)(wl + OFF_WD1), 0, nullptr, nullptr, nullptr, nullptr, scr, r, flane()); continue; } r -= CV_I_D;
        if (r < CV_I_IN) { p0_item(a.in[7] + (size_t)l * DM * INW, DM, INW, (bf16*)(wl + OFF_WIN), 0, a.in[2] + l * DM, a.in[3] + l * DM, vec + V_CSIN, vec + V_BWIN, scr, r, flane()); continue; } r -= CV_I_IN;
        if (r < CV_I_OUT){ p0_item(a.in[14] + (size_t)l * DM * DM, DM, DM, (bf16*)(wl + OFF_WOUT), 0, nullptr, nullptr, nullptr, nullptr, scr, r, flane()); continue; } r -= CV_I_OUT;
        if (r < CV_I_GU) { p0_item(a.in[17] + (size_t)l * DM * DFF, DM, DFF, (bf16*)(wl + OFF_W2A), 1, a.in[15] + l * DM, a.in[16] + l * DM, vec + V_CS2, vec + V_BW2, scr, r, flane()); continue; } r -= CV_I_GU;
        if (r < CV_I_GU) { p0_item(a.in[18] + (size_t)l * DM * DFF, DM, DFF, (bf16*)(wl + OFF_W2A), 2, a.in[15] + l * DM, a.in[16] + l * DM, vec + V_CS2, vec + V_BW2, scr, r, flane()); continue; } r -= CV_I_GU;
        p0_item(a.in[19] + (size_t)l * DFF * DM, DFF, DM, (bf16*)(wl + OFF_WD2), 0, nullptr, nullptr, nullptr, nullptr, scr, r, flane());
    }
}
__device__ __forceinline__ void p0_prologue(Frame& F, const Args& a) {
    const int gw = F.vcu * NWAVES + F.wave, NGW = F.G * NWAVES;
    for (int l = 0; l < DEPTH; ++l) convert_layer_items(F, a, l, 0, (l == 0 || F.G != 256) ? CV_I_LAYER : CV_TAIL_LO, gw, NGW);
    bf16* XN = (bf16*)(a.ws + WS_XN); unsigned char* YL = a.ws + WS_YL;
    pg8::st_t* ST = (pg8::st_t*)(a.ws + WS_ST);
    f32x4 xn[8];
    if (gw < NTOK) { const float* src = gw < S_PROMPT ? a.in[0] + (size_t)gw * DM : a.in[1] + (size_t)(gw - S_PROMPT) * DM; const GAS f32x4* xr = (const GAS f32x4*)src + flane();
#pragma unroll
        for (int j = 0; j < 8; ++j) xn[j] = xr[64 * j]; }
    for (int m = gw; m < NTOK; m += NGW) {
        f32x4 xc[8];
#pragma unroll
        for (int j = 0; j < 8; ++j) xc[j] = xn[j];
        if (m + NGW < NTOK) { const int mn = m + NGW; const float* src = mn < S_PROMPT ? a.in[0] + (size_t)mn * DM : a.in[1] + (size_t)(mn - S_PROMPT) * DM; const GAS f32x4* xr = (const GAS f32x4*)src + flane();
#pragma unroll
            for (int j = 0; j < 8; ++j) xn[j] = xr[64 * j]; }
        GAS unsigned long long* o8 = (GAS unsigned long long*)(XN + (size_t)m * DM) + flane();
#pragma unroll
        for (int j = 0; j < 8; ++j) { const f32x4 v = xc[j]; const unsigned h0 = pg8::cvt_pk_op(v.x, v.y), h1 = pg8::cvt_pk_op(v.z, v.w);
            o8[64 * j] = (unsigned long long)h0 | ((unsigned long long)h1 << 32); }
        if (flane() == 0) { ST[2 * m] = 0; ST[2 * m + 1] = pg8::st_fix((float)DM * (1.0f - LN_EPS)); ST[2 * (NTOK + m)] = 0; ST[2 * (NTOK + m) + 1] = 0; }
    }
    if (gw == 0) { float* id = (float*)(a.ws + WS_ID); for (int e = flane(); e < DM; e += 64) { id[e] = 1.f; id[DM + e] = 0.f; } }
}
__device__ __forceinline__ void ln_phase(Frame& F, const bf16* YH, const unsigned char* YL, float* OUT, const float* g, const float* b) {
    int lane_ = flane(); asm volatile("" : "+v"(lane_));
    const int gw = F.vcu * NWAVES + F.wave, NGW = F.G * NWAVES;
    f32x4 gv[8], bv[8];
#pragma unroll
    for (int j = 0; j < 4; ++j) { const int c = 512 * j + 8 * lane_; gv[2 * j] = *(const GAS f32x4*)(g + c); gv[2 * j + 1] = *(const GAS f32x4*)(g + c + 4); bv[2 * j] = *(const GAS f32x4*)(b + c); bv[2 * j + 1] = *(const GAS f32x4*)(b + c + 4); }
    v4u hn[4];
    if (gw < NTOK) { const GAS v4u* hr = (const GAS v4u*)(YH + (size_t)gw * DM) + lane_;
#pragma unroll
        for (int j = 0; j < 4; ++j) hn[j] = hr[64 * j]; }
    for (int m = gw; m < NTOK; m += NGW) {
        f32x4 v[8]; float s = 0.f;
#pragma unroll
        for (int j = 0; j < 4; ++j) { const v4u h = hn[j];
            v[2 * j] = (f32x4){pg8::op_lo(h.x), pg8::op_hi(h.x), pg8::op_lo(h.y), pg8::op_hi(h.y)};
            v[2 * j + 1] = (f32x4){pg8::op_lo(h.z), pg8::op_hi(h.z), pg8::op_lo(h.w), pg8::op_hi(h.w)};
            s += ((v[2 * j].x + v[2 * j].y) + (v[2 * j].z + v[2 * j].w)) + ((v[2 * j + 1].x + v[2 * j + 1].y) + (v[2 * j + 1].z + v[2 * j + 1].w)); }
        if (m + NGW < NTOK) { const GAS v4u* hr = (const GAS v4u*)(YH + (size_t)(m + NGW) * DM) + lane_;
#pragma unroll
            for (int j = 0; j < 4; ++j) hn[j] = hr[64 * j]; }
        const float mean = wave_sum(s) * (1.f / DM); float s2 = 0.f;
#pragma unroll
        for (int j = 0; j < 8; ++j) { v[j] = v[j] - mean; s2 += (v[j].x * v[j].x + v[j].y * v[j].y) + (v[j].z * v[j].z + v[j].w * v[j].w); }
        const float rstd = 1.f / sqrtf(wave_sum(s2) * (1.f / DM) + LN_EPS);
#pragma unroll
        for (int j = 0; j < 4; ++j) { const int c = 512 * j + 8 * lane_;
            *(GAS f32x4*)(OUT + (size_t)m * DM + c) = v[2 * j] * rstd * gv[2 * j] + bv[2 * j]; *(GAS f32x4*)(OUT + (size_t)m * DM + c + 4) = v[2 * j + 1] * rstd * gv[2 * j + 1] + bv[2 * j + 1]; }
    }
}

struct AUnit { int h, br, base, L, dil, rho, a; };
__device__ __forceinline__ AUnit a_unit_of(int uid) {
    AUnit u; u.h = (uid >> 5) & 7; const int rem = (uid >> 8) * 32 + (uid & 31), blk = rem % 96; u.br = rem / 96; u.dil = 1 << (2 * u.br);
    int S, j; if (blk < 32) { u.base = 0; S = S_PROMPT; j = blk; } else { u.base = S_PROMPT + S_SAMPLE * ((blk - 32) >> 4); S = S_SAMPLE; j = (blk - 32) & 15; }
    u.rho = j % u.dil; u.a = (j / u.dil) * 256; u.L = S / u.dil; return u;
}
__device__ __forceinline__ void attn_a_phase(Frame& F, const bf16* QKV, bf16* OA, float* LSE, char* lds) {
    att::AStage st0, st1; bf16x8 qr[8];
    for (int it = 0;; ++it) {
        const int uid = it * F.G + F.vcu; if (uid >= 2304) break;
        const AUnit u = a_unit_of(uid);
        const int nuid = uid + F.G; att::ANext nx; nx.has = nuid < 2304;
        { const AUnit v = a_unit_of(nx.has ? nuid : uid); nx.Kh = att::secp(QKV, 1, v.h) + (size_t)(v.base + v.rho) * att::HD; nx.Qh = att::secp(QKV, 0, v.h) + (size_t)(v.base + v.rho) * att::HD; nx.Vh = att::secp(QKV, 2, v.h) + (size_t)(v.base + v.rho) * att::HD;
          nx.rstride = (size_t)v.dil * att::HD; nx.a = v.a; nx.L = v.L; }
        att::attn_a_unit(QKV, OA + (size_t)u.br * NTOK * 1024, LSE + (size_t)u.br * NTOK * 8, u.base, u.L, u.dil, u.rho, u.a, u.h, lds, st0, st1, qr, it > 0, nx);
    }
}
__device__ __forceinline__ void attn_a_merge_phase(Frame& F, const bf16* OA, const float* LSE, bf16* Y, const float* g) {
    const int gw = F.vcu * NWAVES + F.wave, NGW = F.G * NWAVES;
    int lane_ = flane(); asm volatile("" : "+v"(lane_));
    for (int m = gw; m < NTOK; m += NGW) att::attn_a_merge_row(OA, LSE, Y, g, m, lane_);
}
__device__ __forceinline__ void kn_phase(Frame& F, const bf16* QKV, gu32* KN) {
    int lane_ = flane(); asm volatile("" : "+v"(lane_));
    LAS unsigned* kl = (LAS unsigned*)(F.lds + KNL_OFF);
    const int gw = F.vcu * NWAVES + F.wave, NGW = F.G * NWAVES;
    for (int m0 = gw; m0 < NTOK; m0 += 6 * NGW) {
        v4u v0[6], v1[6];
#pragma unroll
        for (int k = 0; k < 6; ++k) { const int m = m0 + k * NGW; if (m < NTOK) {
            const GAS v4u* p = (const GAS v4u*)(QKV + ((size_t)(4 * 8 + (lane_ >> 3)) * NTOK + m) * 128 + (lane_ & 7) * 16); v0[k] = p[0]; v1[k] = p[1]; } }
#pragma unroll
        for (int k = 0; k < 6; ++k) { const int m = m0 + k * NGW; if (m < NTOK) {
            float ss = 0.f;
#pragma unroll
            for (int e = 0; e < 4; ++e) { const float a = __uint_as_float(v0[k][e] << 16), b = __uint_as_float(v0[k][e] & 0xffff0000u), c = __uint_as_float(v1[k][e] << 16), d = __uint_as_float(v1[k][e] & 0xffff0000u);
                ss += (a * a + b * b) + (c * c + d * d); }
            ss += __shfl_xor(ss, 1); ss += __shfl_xor(ss, 2);
            const int seq = m < S_PROMPT ? 0 : 1 + ((m - S_PROMPT) >> 12);
            if ((lane_ & 3) == 0) __hip_atomic_fetch_max(kl + seq * 16 + (lane_ >> 2), __float_as_uint(ss), __ATOMIC_RELAXED, __HIP_MEMORY_SCOPE_WORKGROUP); } }
    }
    LDS_WAIT(); __syncthreads();
    int tid_ = ftid(); asm volatile("" : "+v"(tid_));
    if (tid_ < 80) { const unsigned v = kl[tid_]; kl[tid_] = 0u; if (v) __hip_atomic_fetch_max(KN + tid_, v, RLX_AGENT); }
    __syncthreads();
}
__device__ __forceinline__ void attn_b_phase(Frame& F, const bf16* QKV, bf16* Y, const float* q1, const float* k1, const float* q2, const float* k2, const float* subg, int layer, gu32* QH, const float* KN, const bf16* OA, const float* LSE, const float* ga, char* lds) {
    int lane_ = flane(); asm volatile("" : "+v"(lane_));
    const float s1 = wave_sum(q1[lane_] * k1[lane_]), s2 = wave_sum(q2[lane_] * k2[lane_]);
    const float lam_init = 0.8f - 0.6f * expf(-0.3f * (float)layer), lam = __uint_as_float(__builtin_amdgcn_readfirstlane(__float_as_uint(expf(s1) - expf(s2) + lam_init)));
    const unsigned xcd = xb_xcc_id() & 7u;
    for (int s = 0; s < 8; ++s) {
        const int q = (int)((xcd + (unsigned)s) & 7u), lo = B_CHUNK[q], hiU = B_CHUNK[q + 1];
        for (;;) {
            if (ftid() == 256) F.MISC[16] = __hip_atomic_fetch_add(QH + 64 * q, 1u, RLX_AGENT);
            __syncthreads();
            const int idx = lo + (int)F.MISC[16];
            __syncthreads();
            if (idx >= hiU) break;
            const unsigned u = B_UNITS[idx];
            if (u >= 0x7000u) {
                const int c0 = (int)(u & 0xfffu) * 96;
                const int ml_ = flane();
                f32x4 gq_[4];
#pragma unroll
                for (int k = 0; k < 4; ++k) gq_[k] = *(const GAS f32x4*)(ga + (ml_ & 7) * 16 + 4 * k);
                for (int m = c0 + F.wave; m < c0 + 96; m += 4 * NWAVES) {
                    att::MergeLoads M0, M1, M2, M3;
                    att::attn_a_merge_load(M0, OA, LSE, m, ml_); att::attn_a_merge_load(M1, OA, LSE, m + NWAVES, ml_); att::attn_a_merge_load(M2, OA, LSE, m + 2 * NWAVES, ml_); att::attn_a_merge_load(M3, OA, LSE, m + 3 * NWAVES, ml_);
                    att::attn_a_merge_finish(M0, Y, gq_, m, ml_); att::attn_a_merge_finish(M1, Y, gq_, m + NWAVES, ml_); att::attn_a_merge_finish(M2, Y, gq_, m + 2 * NWAVES, ml_); att::attn_a_merge_finish(M3, Y, gq_, m + 3 * NWAVES, ml_);
                }
                continue;
            }
            const int seq = (int)(u >> 12), h = (int)((u >> 8) & 7u), qb = (int)(u & 255u);
            const int base = seq == 0 ? 0 : S_PROMPT + S_SAMPLE * (seq - 1), S = seq == 0 ? S_PROMPT : S_SAMPLE;
            att::attn_b_unit(QKV, Y, base, S, h, qb * 128, lam, subg, 1.0f - lam_init, KN + seq * 16 + h * 2, lds);
        }
    }
}
__device__ __forceinline__ void up_tail_convert(Frame& F, const Args& a, int l_next, int part) {
    if (F.G != 256 || l_next >= DEPTH || MK_CIDX < 128) return;
    const int half = CV_TAIL_LO + (CV_I_LAYER - CV_TAIL_LO) / 2, lo = part ? half : CV_TAIL_LO, hi = part ? CV_I_LAYER : half;
    __syncthreads();
    convert_layer_items(F, a, l_next, lo, hi, (MK_CIDX - 128) * NWAVES + F.wave, 128 * NWAVES);
}
#if MK_STAG50
__device__ __forceinline__ void stag50(unsigned ticks) { if (blockIdx.x < 128) { const unsigned long long t0 = rt(); while (rt() - t0 < ticks) __builtin_amdgcn_s_sleep(8); } }
#endif
__global__ void __launch_bounds__(NWAVES * 64, 2) mk_fwd(Args args) {
    extern __shared__ __attribute__((aligned(16))) unsigned char lds[];
    Frame F;
    F.lds = (LAS unsigned char*)lds;
    F.MISC = (volatile LAS unsigned*)(F.lds + MISC_OFF);
    F.wave = __builtin_amdgcn_readfirstlane((int)threadIdx.x >> 6);
    F.G = gridDim.x; { const int bx = blockIdx.x; F.vcu = (F.G % 8 == 0) ? (bx % 8) * (F.G / 8) + bx / 8 : bx; }
    unsigned char* ws = args.ws;
    F.ctl = (gu32*)(ws + WS_CTL);
    for (int u = ftid(); u < (LDS_BYTES - LDSCTL_OFF) / 4; u += NWAVES * 64) ((LAS unsigned*)(F.lds + LDSCTL_OFF))[u] = 0u;
    __syncthreads();
    const int lo = args.ph_lo, hi = args.ph_hi;
    XcdBarrier bar; bar.bar = (unsigned*)(F.ctl + CW_BAR); bar.x = 0; bar.st = nullptr;
    if (hi - lo > 1) bar = xcd_barrier_post((unsigned*)(F.ctl + CW_BAR), F.MISC + 8);
#define IN(k) (lo <= (k) && (k) < hi)
#define SEAM(k) do { if (IN(k) && IN((k) + 1)) xcd_barrier(bar); } while (0)
    bf16* XN = (bf16*)(ws + WS_XN); bf16* YB = (bf16*)(ws + WS_Y); bf16* QKV = (bf16*)(ws + WS_QKV); bf16* HB = (bf16*)(ws + WS_QKV);
    float* X = args.out; unsigned char* YLB = ws + WS_YL;

    if (IN(0)) { p0_prologue(F, args); SEAM(0); }
    pg8::st_t* STB = (pg8::st_t*)(ws + WS_ST); const float* IDV = (const float*)(ws + WS_ID);
#define ZERO_ST(p) do { pg8::st_t* z_ = (p) + (size_t)blockIdx.x * (2 * NTOK / 256); if (F.G == 256) { if (ftid() < 2 * NTOK / 256) z_[ftid()] = 0; } else if (blockIdx.x == 0) { for (int e_ = ftid(); e_ < 2 * NTOK; e_ += NWAVES * 64) (p)[e_] = 0; } } while (0)
    for (int l = 0; l < DEPTH; ++l) {
        const int pb = 1 + PH_PER_LAYER * l;
        unsigned char* wl = ws + WS_W + (size_t)l * SZ_LAYER;
        const pg8::vec_t* vec = (const pg8::vec_t*)(ws + WS_VEC) + (size_t)l * V_LAYER;
        const int par0 = __builtin_amdgcn_readfirstlane((3 * l) & 1);
        pg8::st_t* ST0 = STB + (size_t)par0 * (2 * NTOK); pg8::st_t* ST1 = STB + (size_t)(par0 ^ 1) * (2 * NTOK);
        if (IN(pb + 0)) {
            ZERO_ST(ST1);
            pg8::Gemm g{XN, (const bf16*)(wl + OFF_W1A), NTOK, NFF2, DM}; pg8::StaticOrder S; S.init(NTOK, NFF2, F.G, MK_CIDX, MK_WGM_UP);
            pg8::EpiSwigluLN E{HB, DFF, ST0, vec + V_CS1, vec + V_BW1};
#if MK_DUP_UP == 1
            _Pragma("nounroll") for (int rep_ = 0; rep_ < 2; ++rep_) { asm volatile("" ::: "memory"); __syncthreads();
#endif
#if MK_DUP_UP == 2
            { pg8::EpiNull EN; pg8::gemm_phase<pg8::EpiNull, pg8::StaticOrder, true, true>(F.lds + RING_OFF, g, S, EN); __syncthreads(); }
#endif
            pg8::gemm_phase<pg8::EpiSwigluLN, pg8::StaticOrder, MK_ALIGN_UP, MK_SP2>(F.lds + RING_OFF, g, S, E);
#if MK_DUP_UP == 1
            }
#endif
            up_tail_convert(F, args, l + 1, 0);
            SEAM(pb + 0);
        }
        if (IN(pb + 1)) {
            pg8::Gemm g{HB, (const bf16*)(wl + OFF_WD1), NTOK, DM, DFF}; pg8::StaticOrder S; S.init(NTOK, DM, F.G, MK_CIDX, 4);

#if MK_STAG50
            stag50(MK_STAG50);
#endif
            pg8::EpiResidLN E{XN, YLB, XN, YLB, DM, ST0, ST1, l ? args.in[20] + (l - 1) * DM : IDV, l ? args.in[21] + (l - 1) * DM : IDV + DM, ALPHA, 0.5f};
#if MK_DUP_DOWN == 1
            _Pragma("nounroll") for (int rep_ = 0; rep_ < 2; ++rep_) { asm volatile("" ::: "memory"); __syncthreads();
            E.YHo = rep_ ? XN : (bf16*)(ws + WS_OA); E.YLo = rep_ ? YLB : ws + WS_OA + SZ_XN; E.STn = rep_ ? ST1 : (pg8::st_t*)(ws + WS_LSE);
#endif
#if MK_DUP_DOWN == 2
            { pg8::EpiNull EN; pg8::gemm_phase<pg8::EpiNull, pg8::StaticOrder, true, true>(F.lds + RING_OFF, g, S, EN); __syncthreads(); }
#endif
            pg8::gemm_phase<pg8::EpiResidLN, pg8::StaticOrder, MK_ALIGN_RESID, MK_SP2, MK_AUX_RESID>(F.lds + RING_OFF, g, S, E);
#if MK_DUP_DOWN == 1
            }
#endif
            SEAM(pb + 1);
        }
        if (IN(pb + 2)) {
            ZERO_ST(ST0);
            pg8::Gemm g{XN, (const bf16*)(wl + OFF_WIN), NTOK, INW, DM}; pg8::StaticOrder S; S.init(NTOK, INW, F.G, MK_CIDX, MK_WGM_UP);
            pg8::EpiBf16LN E{QKV, NTOK, ST1, vec + V_CSIN, vec + V_BWIN};
#if MK_DUP_WIN
            _Pragma("nounroll") for (int rep_ = 0; rep_ < 2; ++rep_) { asm volatile("" ::: "memory"); __syncthreads();
#endif
            pg8::gemm_phase<pg8::EpiBf16LN, pg8::StaticOrder, true, MK_SP2>(F.lds + RING_OFF, g, S, E);
#if MK_DUP_WIN
            }
#endif
            SEAM(pb + 2);
        }
        if (IN(pb + 3)) {
            kn_phase(F, QKV, F.ctl + CW_KN + l * 80);
            attn_a_phase(F, QKV, (bf16*)(ws + WS_OA), (float*)(ws + WS_LSE), (char*)lds + RING_OFF);
#if MK_DUP_A
            __syncthreads();
            attn_a_phase(F, QKV, (bf16*)(ws + WS_OA), (float*)(ws + WS_LSE), (char*)lds + RING_OFF);
#endif
            SEAM(pb + 3);
        }
        if (IN(pb + 4)) {
            attn_b_phase(F, QKV, YB, args.in[9] + l * 64, args.in[10] + l * 64, args.in[11] + l * 64, args.in[12] + l * 64, args.in[13] + l * 128, l, F.ctl + CW_QH + l * 512, (const float*)(ws + WS_CTL) + CW_KN + l * 80, (const bf16*)(ws + WS_OA), (const float*)(ws + WS_LSE), args.in[8] + l * 128, (char*)lds + RING_OFF);

            SEAM(pb + 4);
        }
        if (IN(pb + 5)) {
            pg8::Gemm g{YB, (const bf16*)(wl + OFF_WOUT), NTOK, DM, DM}; pg8::StaticOrder S; S.init(NTOK, DM, F.G, MK_CIDX, 4);
            pg8::EpiResidLN E{XN, YLB, XN, YLB, DM, ST1, ST0, args.in[2] + l * DM, args.in[3] + l * DM, ALPHA, 1.0f};
#if MK_DUP_WOUT
            _Pragma("nounroll") for (int rep_ = 0; rep_ < 2; ++rep_) { asm volatile("" ::: "memory"); __syncthreads();
            E.YHo = rep_ ? XN : (bf16*)(ws + WS_OA); E.YLo = rep_ ? YLB : ws + WS_OA + SZ_XN; E.STn = rep_ ? ST0 : (pg8::st_t*)(ws + WS_LSE);
#endif
            pg8::gemm_phase<pg8::EpiResidLN, pg8::StaticOrder, MK_ALIGN_RESID, MK_SP2, MK_AUX_RESID>(F.lds + RING_OFF, g, S, E);
#if MK_DUP_WOUT
            }
#endif
            SEAM(pb + 5);
        }
        if (IN(pb + 6)) {
            ZERO_ST(ST1);
            pg8::Gemm g{XN, (const bf16*)(wl + OFF_W2A), NTOK, NFF2, DM}; pg8::StaticOrder S; S.init(NTOK, NFF2, F.G, MK_CIDX, MK_WGM_UP);
            pg8::EpiSwigluLN E{HB, DFF, ST0, vec + V_CS2, vec + V_BW2};
            pg8::gemm_phase<pg8::EpiSwigluLN, pg8::StaticOrder, MK_ALIGN_UP, MK_SP2>(F.lds + RING_OFF, g, S, E);
            up_tail_convert(F, args, l + 1, 1);
            SEAM(pb + 6);
        }
        if (IN(pb + 7)) {
            pg8::Gemm g{HB, (const bf16*)(wl + OFF_WD2), NTOK, DM, DFF}; pg8::StaticOrder S; S.init(NTOK, DM, F.G, MK_CIDX, 4);

#if MK_STAG50
            stag50(MK_STAG50);
#endif
            pg8::EpiResidLN E{XN, YLB, XN, YLB, DM, ST0, ST1, args.in[15] + l * DM, args.in[16] + l * DM, ALPHA, 0.5f};
            pg8::gemm_phase<pg8::EpiResidLN, pg8::StaticOrder, MK_ALIGN_RESID, MK_SP2, MK_AUX_RESID>(F.lds + RING_OFF, g, S, E);
            SEAM(pb + 7);
        }
    }
    if (IN(N_PHASES - 1)) ln_phase(F, XN, YLB, X, args.in[20] + (DEPTH - 1) * DM, args.in[21] + (DEPTH - 1) * DM);
#undef IN
#undef SEAM
}

#if MK_G4TEST
__global__ void __launch_bounds__(256, 1) gemm4_fwd(Args args) {
    extern __shared__ __attribute__((aligned(16))) unsigned char lds4[];
    LAS unsigned char* L = (LAS unsigned char*)lds4;
    unsigned char* ws = args.ws; const int lo = args.ph_lo, hi = args.ph_hi, G = gridDim.x;
    const int wid4 = __builtin_amdgcn_readfirstlane((int)threadIdx.x >> 6);
    bf16* XN = (bf16*)(ws + WS_XN); bf16* YB = (bf16*)(ws + WS_Y); bf16* QKV = (bf16*)(ws + WS_QKV); bf16* HB = (bf16*)(ws + WS_QKV); unsigned char* YLB = ws + WS_YL;
    float* STB = (float*)(ws + WS_ST); const float* IDV = (const float*)(ws + WS_ID);
#define IN(k) (lo <= (k) && (k) < hi)
#define ZST(p) do { const int t_ = wid4 * 64 + pg8::lane_id4(); float* z_ = (p) + (size_t)blockIdx.x * (2 * NTOK / 256); if (t_ < 2 * NTOK / 256) z_[t_] = 0.f; } while (0)
    for (int l = 0; l < DEPTH; ++l) {
        const int pb = 1 + PH_PER_LAYER * l;
        unsigned char* wl = ws + WS_W + (size_t)l * SZ_LAYER;
        const float* vec = (const float*)(ws + WS_VEC) + (size_t)l * V_LAYER;
        float* ST0 = STB + (size_t)((3 * l) & 1) * (2 * NTOK); float* ST1 = STB + (size_t)((3 * l + 1) & 1) * (2 * NTOK);
        if (IN(pb + 0)) { ZST(ST1); pg8::Gemm g{XN, (const bf16*)(wl + OFF_W1A), NTOK, NFF2, DM}; pg8::StaticOrder S; S.init(NTOK, NFF2, G, MK_CIDX);
            pg8::EpiSwigluLN E{HB, DFF, ST0, vec + V_CS1, vec + V_BW1};
#if MK_G4TEST == 2
            { pg8::EpiNull EN; pg8::gemm_phase4<pg8::EpiNull, pg8::StaticOrder>(L, g, S, EN, wid4); }
#endif
            pg8::gemm_phase4<pg8::EpiSwigluLN, pg8::StaticOrder>(L, g, S, E, wid4); }
        if (IN(pb + 1)) { pg8::Gemm g{HB, (const bf16*)(wl + OFF_WD1), NTOK, DM, DFF}; pg8::StaticOrder S; S.init(NTOK, DM, G, MK_CIDX, 4);
            pg8::EpiResidLN E{XN, YLB, XN, YLB, DM, ST0, ST1, l ? args.in[20] + (l - 1) * DM : IDV, l ? args.in[21] + (l - 1) * DM : IDV + DM, ALPHA, 0.5f}; pg8::gemm_phase4<pg8::EpiResidLN, pg8::StaticOrder>(L, g, S, E, wid4); }
        if (IN(pb + 2)) { ZST(ST0); pg8::Gemm g{XN, (const bf16*)(wl + OFF_WIN), NTOK, INW, DM}; pg8::StaticOrder S; S.init(NTOK, INW, G, MK_CIDX);
            pg8::EpiBf16LN E{QKV, NTOK, ST1, vec + V_CSIN, vec + V_BWIN}; pg8::gemm_phase4<pg8::EpiBf16LN, pg8::StaticOrder>(L, g, S, E, wid4); }
        if (IN(pb + 5)) { pg8::Gemm g{YB, (const bf16*)(wl + OFF_WOUT), NTOK, DM, DM}; pg8::StaticOrder S; S.init(NTOK, DM, G, MK_CIDX, 4);
            pg8::EpiResidLN E{XN, YLB, XN, YLB, DM, ST1, ST0, args.in[2] + l * DM, args.in[3] + l * DM, ALPHA, 1.0f}; pg8::gemm_phase4<pg8::EpiResidLN, pg8::StaticOrder>(L, g, S, E, wid4); }
        if (IN(pb + 6)) { ZST(ST1); pg8::Gemm g{XN, (const bf16*)(wl + OFF_W2A), NTOK, NFF2, DM}; pg8::StaticOrder S; S.init(NTOK, NFF2, G, MK_CIDX);
            pg8::EpiSwigluLN E{HB, DFF, ST0, vec + V_CS2, vec + V_BW2}; pg8::gemm_phase4<pg8::EpiSwigluLN, pg8::StaticOrder>(L, g, S, E, wid4); }
        if (IN(pb + 7)) { pg8::Gemm g{HB, (const bf16*)(wl + OFF_WD2), NTOK, DM, DFF}; pg8::StaticOrder S; S.init(NTOK, DM, G, MK_CIDX, 4);
            pg8::EpiResidLN E{XN, YLB, XN, YLB, DM, ST0, ST1, args.in[15] + l * DM, args.in[16] + l * DM, ALPHA, 0.5f}; pg8::gemm_phase4<pg8::EpiResidLN, pg8::StaticOrder>(L, g, S, E, wid4); }
    }
#undef IN
#undef ZST
}
#endif

extern "C" void kernel_launch(void* const* d_in, const int* in_sizes, int n_in, void* d_out, int out_size, void* d_ws, size_t ws_size, hipStream_t stream) {
    static int grid = 0;
    if (grid == 0) {
        const size_t need = WS_END;
        if (n_in != NIN || out_size != NTOK * DM || ws_size < need) { fprintf(stderr, "kernel_launch: shape mismatch n_in %d out %d ws %zu (need %zu)\n", n_in, out_size, ws_size, need); grid = -1; return; }
        int dev = 0, cus = 0;
        if (hipGetDevice(&dev) != hipSuccess || hipDeviceGetAttribute(&cus, hipDeviceAttributeMultiprocessorCount, dev) != hipSuccess) { grid = -1; return; }
        if (hipFuncSetAttribute((const void*)mk_fwd, hipFuncAttributeMaxDynamicSharedMemorySize, LDS_BYTES) != hipSuccess) { fprintf(stderr, "kernel_launch: hipFuncSetAttribute failed\n"); grid = -1; return; }
        int per_cu = 0;
        if (hipOccupancyMaxActiveBlocksPerMultiprocessor(&per_cu, (const void*)mk_fwd, NWAVES * 64, LDS_BYTES) != hipSuccess || per_cu < 1) fprintf(stderr, "kernel_launch: occupancy query says %d\n", per_cu);
        (void)hipGetLastError();
        grid = cus;
    }
    if (grid < 0) return;
    if (hipMemsetAsync((char*)d_ws + WS_CTL, 0, CTL_ZERO_BYTES, stream) != hipSuccess) return;
    Args a{};
    for (int i = 0; i < NIN; ++i) a.in[i] = (const float*)d_in[i];
    a.out = (float*)d_out; a.ws = (unsigned char*)d_ws;
#if MK_G4TEST
    { static int once = 0; if (!once) { once = 1; if (hipFuncSetAttribute((const void*)gemm4_fwd, hipFuncAttributeMaxDynamicSharedMemorySize, 135168) != hipSuccess) fprintf(stderr, "gemm4 attr failed\n"); } }
    for (int p = 0; p < N_PHASES; ++p) {
        const int k = (p >= 1 && p <= DEPTH * PH_PER_LAYER) ? (p - 1) % PH_PER_LAYER : -1;
        a.ph_lo = p; a.ph_hi = p + 1;
        if (k == 0 || k == 1 || k == 2 || k == 5 || k == 6 || k == 7) hipLaunchKernelGGL(gemm4_fwd, dim3(grid), dim3(256), 135168, stream, a);
        else hipLaunchKernelGGL(mk_fwd, dim3(grid), dim3(NWAVES * 64), LDS_BYTES, stream, a);
    }
#else
    a.ph_lo = 0; a.ph_hi = N_PHASES;
    hipLaunchKernelGGL(mk_fwd, dim3(grid), dim3(NWAVES * 64), LDS_BYTES, stream, a);
#endif
    const hipError_t le = hipPeekAtLastError();
    if (le != hipSuccess) fprintf(stderr, "kernel_launch: launch failed: %s\n", hipGetErrorName(le));
}
```
